# Optimizing an MI355X kernel written in HIP

```python
import math
import jax, jax.numpy as jnp
from jax import lax
import numpy as np

D_MODEL = 2048
BATCH = 4
SEQ = 4096
DEPTH = 2

N_HEADS = 16
HEAD_DIM = 128
N_KV = 4
GROUP = N_HEADS // N_KV
CMP_LEN = 32
CMP_STRIDE = 16
CMP_HIDDEN = 256
SEL_LEN = 64
N_SEL = 16
WINDOW = 512
Q_CHUNK = 32
ATTN_DIM = N_HEADS * HEAD_DIM
KV_DIM = N_KV * HEAD_DIM
N_NSA_BRANCH = 3
CONV_DIM = D_MODEL
CONV_WIDTH = 3
D_FF = 4 * D_MODEL
N_MERGE = 2
ROPE_THETA = 10000.0
EPS = 1e-6
SPLITS = [ATTN_DIM, 6 * KV_DIM, N_HEADS * N_NSA_BRANCH, 3 * CONV_DIM, N_MERGE * D_MODEL]
IN_COLS = sum(SPLITS)

kernel_name = "hybrid_nsa_shortconv_sqrelu"


def rmsnorm(x, g):
    xf = x.astype(jnp.float32)
    y = xf * lax.rsqrt(jnp.mean(xf * xf, axis=-1, keepdims=True) + EPS)
    return (y * g.astype(jnp.float32)).astype(x.dtype)


def rope(x, pos):
    half = x.shape[-1] // 2
    inv_freq = jnp.exp(-math.log(ROPE_THETA) * jnp.arange(half, dtype=jnp.float32) / half)
    ang = pos.astype(jnp.float32)[:, None] * inv_freq[None, :]
    cos, sin = jnp.cos(ang), jnp.sin(ang)
    xf = x.astype(jnp.float32)
    x1, x2 = xf[..., :half], xf[..., half:]
    out = jnp.concatenate([x1 * cos - x2 * sin, x2 * cos + x1 * sin], axis=-1)
    return out.astype(x.dtype)


def masked_softmax(s, mask):
    s = jnp.where(mask, s.astype(jnp.float32), -jnp.inf)
    m = jnp.max(s, axis=-1, keepdims=True)
    m = jnp.where(jnp.isfinite(m), m, 0.0)
    p = jnp.exp(s - m)
    d = jnp.sum(p, axis=-1, keepdims=True)
    return p / jnp.where(d > 0, d, 1.0)


def compress(k, pos_emb, w1, w2):
    b, g, s, dh = k.shape
    nc = (s - CMP_LEN) // CMP_STRIDE + 1
    idx = jnp.arange(nc)[:, None] * CMP_STRIDE + jnp.arange(CMP_LEN)[None, :]
    blocks = k[:, :, idx] + pos_emb
    flat = blocks.reshape(b, g, nc, CMP_LEN * dh)
    return jax.nn.silu(flat @ w1) @ w2


def cmp_to_sel_matrix(nc, ns):
    cs = np.arange(nc) * CMP_STRIDE
    ss = np.arange(ns) * SEL_LEN
    ov = np.minimum(cs[:, None] + CMP_LEN, ss[None, :] + SEL_LEN) - np.maximum(cs[:, None], ss[None, :])
    return jnp.asarray(np.clip(ov, 0, None) / CMP_LEN, dtype=jnp.float32)


def nsa_attention(q, kc, vc, ks, vs, kw, vw):
    b, g, r, s, dh = q.shape
    nc = kc.shape[2]
    ns = s // SEL_LEN
    n_sel = min(N_SEL, ns)
    nq = s // Q_CHUNK
    scale = dh ** -0.5
    cmp_end = jnp.arange(nc) * CMP_STRIDE + CMP_LEN - 1
    m_sel = cmp_to_sel_matrix(nc, ns)
    ks_blk = ks.reshape(b, g, ns, SEL_LEN, dh)
    vs_blk = vs.reshape(b, g, ns, SEL_LEN, dh)
    pad = jnp.zeros((b, g, WINDOW, dh), kw.dtype)
    kw_pad = jnp.concatenate([pad, kw], axis=2)
    vw_pad = jnp.concatenate([pad, vw], axis=2)
    bi = jnp.arange(b)[:, None, None, None]
    gi = jnp.arange(g)[None, :, None, None]
    blk_ids = jnp.arange(ns)
    tok_in_blk = jnp.arange(SEL_LEN)
    win_off = jnp.arange(WINDOW + Q_CHUNK)
    q_chunks = jnp.moveaxis(q.reshape(b, g, r, nq, Q_CHUNK, dh), 3, 0)

    def chunk(args):
        qc, c = args
        start = c * Q_CHUNK
        t = start + jnp.arange(Q_CHUNK)
        sc = jnp.einsum('bgrqd,bgnd->bgrqn', qc, kc) * scale
        p_cmp = masked_softmax(sc, cmp_end[None, :] <= t[:, None])
        o_cmp = jnp.einsum('bgrqn,bgnd->bgrqd', p_cmp.astype(vc.dtype), vc)
        imp = jnp.einsum('bgrqn,nm->bgqm', p_cmp, m_sel)
        tb = t // SEL_LEN
        valid = blk_ids[None, :] <= tb[:, None]
        forced = (blk_ids[None, :] == 0) | (blk_ids[None, :] == tb[:, None]) | (blk_ids[None, :] == tb[:, None] - 1)
        imp = jnp.where(valid, jnp.where(forced, jnp.inf, imp), -jnp.inf)
        _, idx = lax.top_k(imp, n_sel)
        kg = ks_blk[bi, gi, idx]
        vg = vs_blk[bi, gi, idx]
        ss_ = jnp.einsum('bgrqd,bgqnld->bgrqnl', qc, kg) * scale
        tok = idx[..., None] * SEL_LEN + tok_in_blk
        smask = (tok <= t[None, None, :, None, None])[:, :, None]
        shp = ss_.shape
        p_sel = masked_softmax(ss_.reshape(b, g, r, Q_CHUNK, -1),
                               smask.reshape(b, g, 1, Q_CHUNK, -1)).reshape(shp)
        o_sel = jnp.einsum('bgrqnl,bgqnld->bgrqd', p_sel.astype(vg.dtype), vg)
        kwc = lax.dynamic_slice_in_dim(kw_pad, start, WINDOW + Q_CHUNK, axis=2)
        vwc = lax.dynamic_slice_in_dim(vw_pad, start, WINDOW + Q_CHUNK, axis=2)
        kp = start - WINDOW + win_off
        wmask = (kp[None, :] <= t[:, None]) & (t[:, None] - kp[None, :] < WINDOW) & (kp[None, :] >= 0)
        sw = jnp.einsum('bgrqd,bgkd->bgrqk', qc, kwc) * scale
        p_win = masked_softmax(sw, wmask)
        o_win = jnp.einsum('bgrqk,bgkd->bgrqd', p_win.astype(vwc.dtype), vwc)
        return o_cmp, o_sel, o_win

    outs = lax.map(chunk, (q_chunks, jnp.arange(nq)))
    return [jnp.moveaxis(o, 0, 3).reshape(b, g, r, s, dh) for o in outs]


def short_conv(u, w):
    c = u.shape[-1]
    return lax.conv_general_dilated(u, w[:, None, :].astype(u.dtype), window_strides=(1,),
                                    padding=[(CONV_WIDTH - 1, 0)],
                                    dimension_numbers=('NWC', 'WIO', 'NWC'),
                                    feature_group_count=c)


def setup_inputs(seed: int = 0) -> dict:
    key = jax.random.key(seed)
    ks = jax.random.split(key, 20)
    f32 = jnp.float32
    nrm = lambda k, shape, fan: jax.random.normal(k, shape, f32) * (fan ** -0.5)
    gain = lambda k, shape: 1.0 + 0.02 * jax.random.normal(k, shape, f32)
    L = DEPTH
    return {
        "x": jax.random.normal(ks[0], (BATCH, SEQ, D_MODEL), f32),
        "norm1_g": gain(ks[1], (L, D_MODEL)),
        "w_in": nrm(ks[2], (L, D_MODEL, IN_COLS), D_MODEL),
        "cmp_pos_k": 0.1 * jax.random.normal(ks[3], (L, CMP_LEN, HEAD_DIM), f32),
        "cmp_w1_k": nrm(ks[4], (L, CMP_LEN * HEAD_DIM, CMP_HIDDEN), CMP_LEN * HEAD_DIM),
        "cmp_w2_k": nrm(ks[5], (L, CMP_HIDDEN, HEAD_DIM), CMP_HIDDEN),
        "cmp_pos_v": 0.1 * jax.random.normal(ks[6], (L, CMP_LEN, HEAD_DIM), f32),
        "cmp_w1_v": nrm(ks[7], (L, CMP_LEN * HEAD_DIM, CMP_HIDDEN), CMP_LEN * HEAD_DIM),
        "cmp_w2_v": nrm(ks[8], (L, CMP_HIDDEN, HEAD_DIM), CMP_HIDDEN),
        "conv_w": nrm(ks[9], (L, CONV_WIDTH, CONV_DIM), CONV_WIDTH),
        "w_attn_proj": nrm(ks[10], (L, ATTN_DIM, D_MODEL), ATTN_DIM),
        "w_conv_out": nrm(ks[11], (L, CONV_DIM, D_MODEL), CONV_DIM),
        "w_o": nrm(ks[12], (L, D_MODEL, D_MODEL), D_MODEL),
        "norm2_g": gain(ks[13], (L, D_MODEL)),
        "w_up": nrm(ks[14], (L, D_MODEL, D_FF), D_MODEL),
        "w_down": nrm(ks[15], (L, D_FF, D_MODEL), D_FF),
        "final_g": gain(ks[16], (D_MODEL,)),
    }


def reference(x, norm1_g, w_in, cmp_pos_k, cmp_w1_k, cmp_w2_k, cmp_pos_v, cmp_w1_v, cmp_w2_v,
              conv_w, w_attn_proj, w_conv_out, w_o, norm2_g, w_up, w_down, final_g):
    b, s, _ = x.shape
    pos = jnp.arange(s)
    nc = (s - CMP_LEN) // CMP_STRIDE + 1
    cmp_pos = jnp.arange(nc) * CMP_STRIDE + CMP_LEN - 1
    offsets = np.cumsum(SPLITS)[:-1].tolist()
    for i in range(DEPTH):
        h = rmsnorm(x, norm1_g[i])
        z = h @ w_in[i]
        q, kv, ng, cv, mg = jnp.split(z, offsets, axis=-1)
        q = rope(q.reshape(b, s, N_KV, GROUP, HEAD_DIM).transpose(0, 2, 3, 1, 4), pos)
        kv = kv.reshape(b, s, 6, N_KV, HEAD_DIM)
        k_cmp, v_cmp, k_sel, v_sel, k_win, v_win = [kv[:, :, j].transpose(0, 2, 1, 3) for j in range(6)]
        kc = rope(compress(k_cmp, cmp_pos_k[i], cmp_w1_k[i], cmp_w2_k[i]), cmp_pos)
        vc = compress(v_cmp, cmp_pos_v[i], cmp_w1_v[i], cmp_w2_v[i])
        o_cmp, o_sel, o_win = nsa_attention(q, kc, vc, rope(k_sel, pos), v_sel, rope(k_win, pos), v_win)
        to_bshd = lambda o: o.transpose(0, 3, 1, 2, 4).reshape(b, s, N_HEADS, HEAD_DIM)
        gb = jax.nn.sigmoid(ng.reshape(b, s, N_HEADS, N_NSA_BRANCH).astype(jnp.float32)).astype(x.dtype)
        o_attn = (gb[..., 0:1] * to_bshd(o_cmp) + gb[..., 1:2] * to_bshd(o_sel)
                  + gb[..., 2:3] * to_bshd(o_win)).reshape(b, s, ATTN_DIM)
        y_attn = o_attn @ w_attn_proj[i]
        x_in, gate_b, gate_c = jnp.split(cv, 3, axis=-1)
        y_conv = (gate_b * short_conv(gate_c * x_in, conv_w[i])) @ w_conv_out[i]
        gm = jax.nn.sigmoid(mg.astype(jnp.float32)).astype(x.dtype)
        g_attn, g_conv = jnp.split(gm, 2, axis=-1)
        x = x + (g_attn * y_attn + g_conv * y_conv) @ w_o[i]
        h2 = rmsnorm(x, norm2_g[i])
        x = x + jnp.square(jax.nn.relu(h2 @ w_up[i])) @ w_down[i]
    return rmsnorm(x, final_g)
```

```cpp
#include <hip/hip_runtime.h>
#include <hip/hip_cooperative_groups.h>
#include <cstdio>
#include <cstdint>
namespace cg = cooperative_groups;

#define LAS __attribute__((address_space(3)))
typedef unsigned short bf16_t;
typedef short bf16x8 __attribute__((ext_vector_type(8)));
typedef short bf16x4 __attribute__((ext_vector_type(4)));
typedef float f32x4 __attribute__((ext_vector_type(4)));
typedef unsigned u32x4 __attribute__((ext_vector_type(4)));
typedef unsigned u32x2 __attribute__((ext_vector_type(2)));

constexpr int T = 16384, DM = 2048, SEQ = 4096, NBATCH = 4, DEPTH = 2;
constexpr int IN_COLS = 15408, NIN = 15616;
constexpr int FF = 8192;
constexpr float EPS = 1e-6f;
constexpr float QSCALE = 0.08838834764831845f * 1.4426950408889634f;

constexpr size_t MiB = 1u << 20;
constexpr size_t WS_Q = 0, WS_KV = 64 * MiB, WS_CV = 160 * MiB, WS_MG = 352 * MiB;
constexpr size_t WS_H = 0, WS_MP = 160 * MiB, WS_MB = 288 * MiB;
constexpr size_t WS_XB = 480 * MiB, WS_OATT = 480 * MiB, WS_VB = 544 * MiB;
constexpr size_t WS_WIN = 608 * MiB, WS_WAP = 730 * MiB, WS_WCO = 746 * MiB, WS_WO = 762 * MiB, WS_WUP = 778 * MiB, WS_WDN = 842 * MiB;
constexpr size_t WS_CW1 = 906 * MiB, WS_CW2 = 914 * MiB, WS_HID = 915 * MiB, WS_KC = 919 * MiB, WS_VCT = 920 * MiB, WS_NG = 921 * MiB;
constexpr size_t WS_ROPE = 924 * MiB, WS_SS = 926 * MiB, WS_CB = 927 * MiB, WS_C2T = 928 * MiB, WS_BAR = 932 * MiB, WS_END = 933 * MiB;
constexpr size_t KVJ = (size_t)16 * SEQ * 128;

struct Params {
    const float* in[17];
    float* out;
    unsigned char* ws;
    int lo, hi, coop, pad;
};

__device__ __forceinline__ unsigned cvt_pk_bf16(float lo, float hi) { unsigned r; asm volatile("v_cvt_pk_bf16_f32 %0, %1, %2" : "=v"(r) : "v"(lo), "v"(hi)); return r; }
__device__ __forceinline__ float bf2f(unsigned short v) { return __uint_as_float(((unsigned)v) << 16); }
__device__ __forceinline__ float bflo(unsigned w) { return __uint_as_float(w << 16); }
__device__ __forceinline__ float bfhi(unsigned w) { return __uint_as_float(w & 0xffff0000u); }
__device__ __forceinline__ float sigmoidf_(float x) { return __builtin_amdgcn_rcpf(1.0f + __builtin_amdgcn_exp2f(-1.4426950408889634f * x)); }
__device__ __forceinline__ int ropeperm(int p) { const int t = p >> 2, j = p & 3; return 2 * t + (j >> 1) + 64 * (j & 1); }

namespace pg8 {
constexpr int BM = 256, BK = 64, HALF = 128, HTB = HALF * BK * 2, STAGE_BYTES = 8 * HTB, NXCD = 8, WGM = 8;
__device__ __forceinline__ int lds_byte(int r, int c) { const int st = (r >> 4) * 2 + (c >> 5), rr = r & 15, cc = c & 31, ob = rr * 64 + cc * 2; return st * 1024 + (ob ^ (((ob >> 9) & 1) << 5)); }
__device__ __forceinline__ void stage_rc(int b, int& R, int& C) { const int st = b / 1024, sb = b % 1024, swz = sb ^ (((sb >> 9) & 1) << 5); R = (st >> 1) * 16 + swz / 64; C = (st & 1) * 32 + (swz % 64) / 2; }
__device__ __forceinline__ int perm32(int rho) { const int n = rho >> 4, i = rho & 15; return 8 * (i >> 2) + 4 * n + (i & 3); }
struct Unit { int pm, pn; };
struct Gemm { const bf16_t* A; const bf16_t* Bt; int M, N, K, lda, ldb; };
struct StaticOrder {
    int nM, nN, nwg, G, c;
    __device__ __forceinline__ void init(int M, int N, int G_, int c_) { nM = M / BM; nN = N / BM; nwg = nM * nN; G = G_; c = c_; }
    __device__ __forceinline__ bool next(int i, Unit& u) const {
        const long L = (long)i * G + c; if (L >= nwg) return false;
        int wgid = (int)L; { const int q = nwg / NXCD, r = nwg % NXCD, xcd = wgid % NXCD, off = wgid / NXCD; wgid = (xcd < r ? xcd * (q + 1) : r * (q + 1) + (xcd - r) * q) + off; }
        const int nig = WGM * nN, gid = wgid / nig, fm = gid * WGM, gsz = (nM - fm) < WGM ? (nM - fm) : WGM;
        u.pm = fm + ((wgid % nig) % gsz); u.pn = (wgid % nig) / gsz; return true;
    }
};
template <class Epi>
__device__ __forceinline__ void gemm_phase(LAS unsigned char* lds, const Gemm g, const StaticOrder& S, const Epi& E) {
    int tid = threadIdx.x; asm volatile("" : "+v"(tid));
    const int wid = __builtin_amdgcn_readfirstlane(tid >> 6), lane = tid & 63, wr = wid >> 2, wc = wid & 3, fr = lane & 15, fq = lane >> 4;
    const int K = g.K, nt = K / BK;
    unsigned voffA[2], voffB[2];
#pragma unroll
    for (int i = 0; i < 2; ++i) { int R, C; stage_rc(tid * 16 + i * 8192, R, C); const int Rb = Epi::PERM ? ((R & ~31) + perm32(R & 31)) : R;
        voffA[i] = (unsigned)(R * g.lda + C) * 2u; voffB[i] = (unsigned)(Rb * g.ldb + C) * 2u; }
    const size_t kstep = (size_t)(BK * 2);
    const size_t hstepA = (size_t)HALF * g.lda * 2, hstepB = (size_t)HALF * g.ldb * 2;
    const size_t tstepA = 2 * hstepA, tstepB = 2 * hstepB;
    const unsigned ldsw = (unsigned)wid * 1024u;
    const int aoff = lds_byte(wr * 64 + fr, fq * 8), boff = lds_byte(wc * 32 + fr, fq * 8);
#define PG8_SA(b, h) (((b) * 2 + (h)) * HTB)
#define PG8_SB(b, h) ((4 + (b) * 2 + (h)) * HTB)
#define PG8_STAGE(bufoff, gbase, voff) do { _Pragma("unroll") for (int _i = 0; _i < 2; ++_i) \
        __builtin_amdgcn_global_load_lds((const unsigned*)((const char*)(gbase) + (voff)[_i]), (LAS unsigned*)(lds + (bufoff) + ldsw + _i * 8192), 16, 0, 0); } while (0)
#define PG8_LDA(dst, b, h) do { _Pragma("unroll") for (int m = 0; m < 4; ++m) _Pragma("unroll") for (int k = 0; k < 2; ++k) dst[m][k] = *(const LAS bf16x8*)(lds + PG8_SA(b, h) + aoff + m * 2048 + k * 1024); } while (0)
#define PG8_LDB(dst, b, h) do { _Pragma("unroll") for (int n = 0; n < 2; ++n) _Pragma("unroll") for (int k = 0; k < 2; ++k) dst[n][k] = *(const LAS bf16x8*)(lds + PG8_SB(b, h) + boff + n * 2048 + k * 1024); } while (0)
#define PG8_MMA(ai, bj, At, Bt) do { __builtin_amdgcn_s_setprio(1); _Pragma("unroll") for (int m = 0; m < 4; ++m) _Pragma("unroll") for (int n = 0; n < 2; ++n) _Pragma("unroll") for (int k = 0; k < 2; ++k) \
        acc[ai][bj][m][n] = __builtin_amdgcn_mfma_f32_16x16x32_bf16(Bt[n][k], At[m][k], acc[ai][bj][m][n], 0, 0, 0); __builtin_amdgcn_s_setprio(0); } while (0)
#define PG8_WAIT_V(n) asm volatile("s_waitcnt vmcnt(" #n ")" ::: "memory")
#define PG8_WAIT_L(n) asm volatile("s_waitcnt lgkmcnt(" #n ")" ::: "memory")
#define PG8_BAR __builtin_amdgcn_s_barrier()
#define PG8_SCHED __builtin_amdgcn_sched_barrier(0)
    Unit cur, nxt; int ui = 0;
    if (!S.next(0, cur)) return;
    f32x4 acc[2][2][4][2];
#pragma unroll
    for (int a = 0; a < 2; ++a)
#pragma unroll
        for (int b = 0; b < 2; ++b)
#pragma unroll
            for (int m = 0; m < 4; ++m)
#pragma unroll
                for (int n = 0; n < 2; ++n) acc[a][b][m][n] = (f32x4){0.f, 0.f, 0.f, 0.f};
    bf16x8 At[4][2], B0[2][2], B1[2][2];
    const char* cA = (const char*)g.A + (size_t)cur.pm * tstepA; const char* cB = (const char*)g.Bt + (size_t)cur.pn * tstepB;
    PG8_STAGE(PG8_SB(0, 0), cB, voffB); PG8_STAGE(PG8_SB(0, 1), cB + hstepB, voffB); PG8_STAGE(PG8_SA(0, 0), cA, voffA); PG8_STAGE(PG8_SA(0, 1), cA + hstepA, voffA);
    if (wr == 1) PG8_BAR;
    PG8_WAIT_V(2); PG8_BAR;
    PG8_STAGE(PG8_SB(1, 0), cB + kstep, voffB); PG8_STAGE(PG8_SA(1, 0), cA + kstep, voffA); PG8_STAGE(PG8_SB(1, 1), cB + hstepB + kstep, voffB);
    PG8_WAIT_V(6); PG8_BAR;
    for (;;) {
        const bool has_next = S.next(ui + 1, nxt);
        const char* nA = has_next ? (const char*)g.A + (size_t)nxt.pm * tstepA : cA; const char* nB = has_next ? (const char*)g.Bt + (size_t)nxt.pn * tstepB : cB;
        for (int t = 0; t < nt; t += 2) {
            const bool last = (t == nt - 2);
            const char* a1 = cA + (size_t)(t + 1) * kstep;
            const char* a2 = last ? nA : cA + (size_t)(t + 2) * kstep; const char* b2 = last ? nB : cB + (size_t)(t + 2) * kstep;
            const char* a3 = a2 + kstep; const char* b3 = b2 + kstep;
            PG8_LDB(B0, 0, 0); PG8_LDB(B1, 0, 1); PG8_SCHED; PG8_LDA(At, 0, 0); PG8_STAGE(PG8_SA(1, 1), a1 + hstepA, voffA);
            PG8_WAIT_V(8); PG8_WAIT_L(0); PG8_BAR; PG8_MMA(0, 0, At, B0); PG8_MMA(0, 1, At, B1); PG8_BAR; PG8_SCHED;
            PG8_LDA(At, 0, 1); PG8_STAGE(PG8_SB(0, 0), b2, voffB); PG8_STAGE(PG8_SB(0, 1), b2 + hstepB, voffB); PG8_STAGE(PG8_SA(0, 0), a2, voffA);
            PG8_WAIT_V(8); PG8_WAIT_L(0); PG8_BAR; PG8_MMA(1, 0, At, B0); PG8_MMA(1, 1, At, B1); PG8_BAR; PG8_SCHED;
            PG8_LDB(B0, 1, 0); PG8_LDB(B1, 1, 1); PG8_SCHED; PG8_LDA(At, 1, 0); PG8_STAGE(PG8_SA(0, 1), a2 + hstepA, voffA);
            PG8_WAIT_V(8); PG8_WAIT_L(0); PG8_BAR; PG8_MMA(0, 0, At, B0); PG8_MMA(0, 1, At, B1); PG8_BAR; PG8_SCHED;
            PG8_LDA(At, 1, 1); PG8_STAGE(PG8_SB(1, 0), b3, voffB); PG8_STAGE(PG8_SB(1, 1), b3 + hstepB, voffB); PG8_STAGE(PG8_SA(1, 0), a3, voffA);
            PG8_WAIT_V(8); PG8_WAIT_L(0); PG8_BAR; PG8_MMA(1, 0, At, B0); PG8_MMA(1, 1, At, B1); PG8_BAR; PG8_SCHED;
        }
        if (wr == 0) PG8_BAR;
        E(acc, cur, wr, wc, fr, fq);
        if (!has_next) break;
#pragma unroll
        for (int a = 0; a < 2; ++a)
#pragma unroll
            for (int b = 0; b < 2; ++b)
#pragma unroll
                for (int m = 0; m < 4; ++m)
#pragma unroll
                    for (int n = 0; n < 2; ++n) acc[a][b][m][n] = (f32x4){0.f, 0.f, 0.f, 0.f};
        cur = nxt; cA = nA; cB = nB; ++ui;
        if (wr == 1) PG8_BAR;
    }
    PG8_WAIT_V(0);
    PG8_BAR;
#undef PG8_SA
#undef PG8_SB
#undef PG8_STAGE
#undef PG8_LDA
#undef PG8_LDB
#undef PG8_MMA
#undef PG8_WAIT_V
#undef PG8_WAIT_L
#undef PG8_BAR
#undef PG8_SCHED
}
}
using pg8::Unit;

__device__ __forceinline__ float qmax(float v) {
    { unsigned a = __float_as_uint(v), b = a; auto r = __builtin_amdgcn_permlane32_swap(a, b, false, false); const unsigned x = r[0], y = r[1]; v = fmaxf(__uint_as_float(x), __uint_as_float(y)); }
    { unsigned a = __float_as_uint(v), b = a; auto r = __builtin_amdgcn_permlane16_swap(a, b, false, false); const unsigned x = r[0], y = r[1]; v = fmaxf(__uint_as_float(x), __uint_as_float(y)); }
    return v;
}
__device__ __forceinline__ float qsum(float v) {
    { unsigned a = __float_as_uint(v), b = a; auto r = __builtin_amdgcn_permlane32_swap(a, b, false, false); const unsigned x = r[0], y = r[1]; v = __uint_as_float(x) + __uint_as_float(y); }
    { unsigned a = __float_as_uint(v), b = a; auto r = __builtin_amdgcn_permlane16_swap(a, b, false, false); const unsigned x = r[0], y = r[1]; v = __uint_as_float(x) + __uint_as_float(y); }
    return v;
}

__device__ __forceinline__ u32x4 pack8(const f32x4 a, const f32x4 b) { u32x4 w; w.x = cvt_pk_bf16(a[0], a[1]); w.y = cvt_pk_bf16(a[2], a[3]); w.z = cvt_pk_bf16(b[0], b[1]); w.w = cvt_pk_bf16(b[2], b[3]); return w; }
__device__ __forceinline__ void rope8(f32x4& v0, f32x4& v1, const f32x4 c4, const f32x4 s4) {
    const f32x4 a = v0, b = v1;
    v0[0] = a[0] * c4[0] - a[1] * s4[0]; v0[1] = a[1] * c4[0] + a[0] * s4[0];
    v0[2] = a[2] * c4[1] - a[3] * s4[1]; v0[3] = a[3] * c4[1] + a[2] * s4[1];
    v1[0] = b[0] * c4[2] - b[1] * s4[2]; v1[1] = b[1] * c4[2] + b[0] * s4[2];
    v1[2] = b[2] * c4[3] - b[3] * s4[3]; v1[3] = b[3] * c4[3] + b[2] * s4[3];
}

struct EpiIn {
    static constexpr bool PERM = true;
    const float* ss; const float* ropec; const float* ropes;
    bf16_t* Q; bf16_t* KV; bf16_t* CV; bf16_t* MG; float* NG;
    enum { M_PLAIN = 0, M_ROPE = 1, M_TRANS = 2, M_SIGM = 3, M_NG = 4 };
    __device__ __forceinline__ void operator()(const f32x4 (&acc)[2][2][4][2], const Unit& u, int wr, int wc, int fr, int fq) const {
        const int pn = u.pn; int mode; bf16_t* base0; bf16_t* base1; size_t bstride; int ld; float scale = 1.f;
        if (pn < 8) { mode = M_ROPE; base0 = Q + (2 * pn) * 128; base1 = base0 + 128; ld = DM; bstride = (size_t)SEQ * DM; scale = QSCALE; }
        else if (pn < 20) { const int hd = (pn - 8) * 2, j = hd >> 2, g = hd & 3; base0 = KV + (size_t)j * KVJ + (size_t)g * SEQ * 128; base1 = base0 + (size_t)SEQ * 128; ld = 128; bstride = (size_t)4 * SEQ * 128;
            mode = (j == 2 || j == 4) ? M_ROPE : ((j == 3 || j == 5) ? M_TRANS : M_PLAIN); }
        else if (pn < 44) { mode = M_PLAIN; base0 = CV + (pn - 20) * 256; base1 = base0 + 128; ld = 3 * DM; bstride = (size_t)SEQ * 3 * DM; }
        else if (pn < 60) { mode = M_SIGM; base0 = MG + (pn - 44) * 256; base1 = base0 + 128; ld = 2 * DM; bstride = (size_t)SEQ * 2 * DM; }
        else { mode = M_NG; base0 = nullptr; base1 = nullptr; ld = 0; bstride = 0; }
        const int p0 = wc * 32 + 8 * fq;
        float rs[8];
#pragma unroll
        for (int i = 0; i < 8; ++i) rs[i] = ss[u.pm * 256 + (i >> 2) * 128 + wr * 64 + (i & 3) * 16 + fr];
#pragma unroll
        for (int i = 0; i < 8; ++i) rs[i] = rsqrtf(rs[i] * (1.0f / DM) + EPS);
#pragma unroll
        for (int ai = 0; ai < 2; ++ai)
#pragma unroll
            for (int m = 0; m < 4; ++m) {
                const int r = u.pm * 256 + ai * 128 + wr * 64 + m * 16 + fr;
                const float rstd = rs[ai * 4 + m];
                const int pos = r & (SEQ - 1), b = r >> 12;
                f32x4 v0 = acc[ai][0][m][0] * rstd, v1 = acc[ai][0][m][1] * rstd, w0 = acc[ai][1][m][0] * rstd, w1 = acc[ai][1][m][1] * rstd;
                const size_t off = (size_t)b * bstride + (size_t)pos * ld + p0;
                if (mode == M_ROPE) {
                    const f32x4 c4 = *(const f32x4*)(ropec + pos * 64 + wc * 16 + 4 * fq), s4 = *(const f32x4*)(ropes + pos * 64 + wc * 16 + 4 * fq);
                    rope8(v0, v1, c4, s4); rope8(w0, w1, c4, s4);
                    *(u32x4*)(base0 + off) = pack8(v0 * scale, v1 * scale); *(u32x4*)(base1 + off) = pack8(w0 * scale, w1 * scale);
                } else if (mode == M_PLAIN) {
                    *(u32x4*)(base0 + off) = pack8(v0, v1); *(u32x4*)(base1 + off) = pack8(w0, w1);
                } else if (mode == M_SIGM) {
#pragma unroll
                    for (int e = 0; e < 4; ++e) { v0[e] = sigmoidf_(v0[e]); v1[e] = sigmoidf_(v1[e]); w0[e] = sigmoidf_(w0[e]); w1[e] = sigmoidf_(w1[e]); }
                    *(u32x4*)(base0 + off) = pack8(v0, v1); *(u32x4*)(base1 + off) = pack8(w0, w1);
                } else if (mode == M_TRANS) {
                    const size_t toff = (size_t)b * bstride + (size_t)p0 * SEQ + pos;
                    { bf16_t* d = base0 + toff; const u32x4 w = pack8(v0, v1);
                      d[0 * SEQ] = (bf16_t)(w.x & 0xffff); d[1 * SEQ] = (bf16_t)(w.x >> 16); d[2 * SEQ] = (bf16_t)(w.y & 0xffff); d[3 * SEQ] = (bf16_t)(w.y >> 16);
                      d[4 * SEQ] = (bf16_t)(w.z & 0xffff); d[5 * SEQ] = (bf16_t)(w.z >> 16); d[6 * SEQ] = (bf16_t)(w.w & 0xffff); d[7 * SEQ] = (bf16_t)(w.w >> 16); }
                    { bf16_t* d = base1 + toff; const u32x4 w = pack8(w0, w1);
                      d[0 * SEQ] = (bf16_t)(w.x & 0xffff); d[1 * SEQ] = (bf16_t)(w.x >> 16); d[2 * SEQ] = (bf16_t)(w.y & 0xffff); d[3 * SEQ] = (bf16_t)(w.y >> 16);
                      d[4 * SEQ] = (bf16_t)(w.z & 0xffff); d[5 * SEQ] = (bf16_t)(w.z >> 16); d[6 * SEQ] = (bf16_t)(w.w & 0xffff); d[7 * SEQ] = (bf16_t)(w.w >> 16); }
                } else {
#pragma unroll
                    for (int e = 0; e < 4; ++e) { if (p0 + e < 48) NG[(size_t)r * 48 + p0 + e] = sigmoidf_(v0[e]); if (p0 + 4 + e < 48) NG[(size_t)r * 48 + p0 + 4 + e] = sigmoidf_(v1[e]); }
                }
            }
    }
};

struct EpiC1S {
    static constexpr bool PERM = false;
    float* HIDP; int row0, coff;
    __device__ __forceinline__ void operator()(const f32x4 (&acc)[2][2][4][2], const Unit& u, int wr, int wc, int fr, int fq) const {
#pragma unroll
        for (int ai = 0; ai < 2; ++ai)
#pragma unroll
            for (int m = 0; m < 4; ++m) {
                float* rp = HIDP + (size_t)(row0 + ai * 128 + wr * 64 + m * 16 + fr) * 512 + coff + wc * 32 + 4 * fq;
#pragma unroll
                for (int bj = 0; bj < 2; ++bj)
#pragma unroll
                    for (int n = 0; n < 2; ++n) *(f32x4*)(rp + bj * 128 + n * 16) = acc[ai][bj][m][n];
            }
    }
};
struct EpiC2 {
    static constexpr bool PERM = false;
    float* C2T;
    __device__ __forceinline__ void operator()(const f32x4 (&acc)[2][2][4][2], const Unit& u, int wr, int wc, int fr, int fq) const {
#pragma unroll
        for (int ai = 0; ai < 2; ++ai)
#pragma unroll
            for (int m = 0; m < 4; ++m) {
                const int r = u.pm * 256 + ai * 128 + wr * 64 + m * 16 + fr;
#pragma unroll
                for (int bj = 0; bj < 2; ++bj)
#pragma unroll
                    for (int n = 0; n < 2; ++n) *(f32x4*)(C2T + (size_t)r * 256 + bj * 128 + wc * 32 + n * 16 + 4 * fq) = acc[ai][bj][m][n];
            }
    }
};
__device__ __forceinline__ void c2_finish_bg(const float* C2T, const float* ropec, const float* ropes, bf16_t* KC, bf16_t* VCT, int bg, int tid) {
    for (int i = tid; i < 256 * 64; i += 512) {
        const int n = i >> 6, f = i & 63, row = bg * 256 + n;
        float o1 = 0.f, o2 = 0.f;
        if (n != 255) { const int pos = 16 * n + 31; const float x1 = C2T[(size_t)row * 256 + 2 * f], x2 = C2T[(size_t)row * 256 + 2 * f + 1], c = ropec[pos * 64 + f], s = ropes[pos * 64 + f]; o1 = x1 * c - x2 * s; o2 = x2 * c + x1 * s; }
        *(unsigned*)(KC + (size_t)row * 128 + 2 * f) = cvt_pk_bf16(o1, o2);
    }
    for (int i = tid; i < 128 * 256; i += 512) {
        const int n = i & 255, d = i >> 8;
        const float v = (n != 255) ? C2T[((size_t)bg * 256 + n) * 256 + 128 + d] : 0.f;
        VCT[((size_t)bg * 128 + d) * 256 + n] = (bf16_t)(cvt_pk_bf16(v, 0.f) & 0xffff);
    }
}
__device__ __forceinline__ void c2_finish(const float* C2T, const float* ropec, const float* ropes, bf16_t* KC, bf16_t* VCT, int gt, int NGT) {
    for (int i = gt; i < 4096 * 64; i += NGT) {
        const int row = i >> 6, f = i & 63, n = row & 255;
        float o1 = 0.f, o2 = 0.f;
        if (n != 255) { const int pos = 16 * n + 31; const float x1 = C2T[(size_t)row * 256 + 2 * f], x2 = C2T[(size_t)row * 256 + 2 * f + 1], c = ropec[pos * 64 + f], s = ropes[pos * 64 + f]; o1 = x1 * c - x2 * s; o2 = x2 * c + x1 * s; }
        *(unsigned*)(KC + (size_t)row * 128 + 2 * f) = cvt_pk_bf16(o1, o2);
    }
    for (int i = gt; i < 16 * 128 * 256; i += NGT) {
        const int n = i & 255, d = (i >> 8) & 127, bg = i >> 15;
        const float v = (n != 255) ? C2T[((size_t)bg * 256 + n) * 256 + 128 + d] : 0.f;
        VCT[i] = (bf16_t)(cvt_pk_bf16(v, 0.f) & 0xffff);
    }
}
struct EpiAP {
    static constexpr bool PERM = true;
    bf16_t* MP; const bf16_t* MG;
    __device__ __forceinline__ void operator()(const f32x4 (&acc)[2][2][4][2], const Unit& u, int wr, int wc, int fr, int fq) const {
#pragma unroll
        for (int ai = 0; ai < 2; ++ai) {
            u32x4 gw[4][2];
#pragma unroll
            for (int m = 0; m < 4; ++m)
#pragma unroll
                for (int bj = 0; bj < 2; ++bj)
                    gw[m][bj] = *(const u32x4*)(MG + (size_t)(u.pm * 256 + ai * 128 + wr * 64 + m * 16 + fr) * 4096 + u.pn * 256 + bj * 128 + wc * 32 + 8 * fq);
#pragma unroll
            for (int m = 0; m < 4; ++m) {
                const int r = u.pm * 256 + ai * 128 + wr * 64 + m * 16 + fr;
#pragma unroll
                for (int bj = 0; bj < 2; ++bj) {
                    const int c = u.pn * 256 + bj * 128 + wc * 32 + 8 * fq;
                    const u32x4 g4 = gw[m][bj];
                    f32x4 v0 = acc[ai][bj][m][0], v1 = acc[ai][bj][m][1];
                    v0[0] *= bflo(g4.x); v0[1] *= bfhi(g4.x); v0[2] *= bflo(g4.y); v0[3] *= bfhi(g4.y);
                    v1[0] *= bflo(g4.z); v1[1] *= bfhi(g4.z); v1[2] *= bflo(g4.w); v1[3] *= bfhi(g4.w);
                    *(u32x4*)(MP + (size_t)r * DM + c) = pack8(v0, v1);
                }
            }
        }
    }
};
struct EpiCO {
    static constexpr bool PERM = true;
    const bf16_t* MP; const bf16_t* MG; bf16_t* MB;
    __device__ __forceinline__ void operator()(const f32x4 (&acc)[2][2][4][2], const Unit& u, int wr, int wc, int fr, int fq) const {
#pragma unroll
        for (int ai = 0; ai < 2; ++ai) {
            u32x4 gw[4][2], mp[4][2];
#pragma unroll
            for (int m = 0; m < 4; ++m)
#pragma unroll
                for (int bj = 0; bj < 2; ++bj) {
                    const size_t r = (size_t)(u.pm * 256 + ai * 128 + wr * 64 + m * 16 + fr); const int c = u.pn * 256 + bj * 128 + wc * 32 + 8 * fq;
                    gw[m][bj] = *(const u32x4*)(MG + r * 4096 + 2048 + c); mp[m][bj] = *(const u32x4*)(MP + r * DM + c);
                }
#pragma unroll
            for (int m = 0; m < 4; ++m)
#pragma unroll
                for (int bj = 0; bj < 2; ++bj) {
                    const size_t r = (size_t)(u.pm * 256 + ai * 128 + wr * 64 + m * 16 + fr); const int c = u.pn * 256 + bj * 128 + wc * 32 + 8 * fq;
                    const u32x4 g4 = gw[m][bj], p4 = mp[m][bj];
                    f32x4 v0 = acc[ai][bj][m][0], v1 = acc[ai][bj][m][1];
                    v0[0] = bflo(p4.x) + v0[0] * bflo(g4.x); v0[1] = bfhi(p4.x) + v0[1] * bfhi(g4.x); v0[2] = bflo(p4.y) + v0[2] * bflo(g4.y); v0[3] = bfhi(p4.y) + v0[3] * bfhi(g4.y);
                    v1[0] = bflo(p4.z) + v1[0] * bflo(g4.z); v1[1] = bfhi(p4.z) + v1[1] * bfhi(g4.z); v1[2] = bflo(p4.w) + v1[2] * bflo(g4.w); v1[3] = bfhi(p4.w) + v1[3] * bfhi(g4.w);
                    *(u32x4*)(MB + r * DM + c) = pack8(v0, v1);
                }
        }
    }
};
struct EpiRes {
    static constexpr bool PERM = true;
    const float* base; float* X; bf16_t* XB; float* ss;
    __device__ __forceinline__ void operator()(const f32x4 (&acc)[2][2][4][2], const Unit& u, int wr, int wc, int fr, int fq) const {
#pragma unroll
        for (int ai = 0; ai < 2; ++ai) {
            f32x4 bs[4][2][2];
#pragma unroll
            for (int m = 0; m < 4; ++m)
#pragma unroll
                for (int bj = 0; bj < 2; ++bj)
#pragma unroll
                    for (int n = 0; n < 2; ++n)
                        bs[m][bj][n] = *(const f32x4*)(base + (size_t)(u.pm * 256 + ai * 128 + wr * 64 + m * 16 + fr) * DM + u.pn * 256 + bj * 128 + wc * 32 + 8 * fq + 4 * n);
#pragma unroll
            for (int m = 0; m < 4; ++m) {
                const int r = u.pm * 256 + ai * 128 + wr * 64 + m * 16 + fr;
                float sq = 0.f;
#pragma unroll
                for (int bj = 0; bj < 2; ++bj) {
                    const int c = u.pn * 256 + bj * 128 + wc * 32 + 8 * fq;
                    const f32x4 v0 = acc[ai][bj][m][0] + bs[m][bj][0], v1 = acc[ai][bj][m][1] + bs[m][bj][1];
                    *(f32x4*)(X + (size_t)r * DM + c) = v0; *(f32x4*)(X + (size_t)r * DM + c + 4) = v1;
                    if (XB) *(u32x4*)(XB + (size_t)r * DM + c) = pack8(v0, v1);
                    sq += ((v0[0] * v0[0] + v0[1] * v0[1]) + (v0[2] * v0[2] + v0[3] * v0[3])) + ((v1[0] * v1[0] + v1[1] * v1[1]) + (v1[2] * v1[2] + v1[3] * v1[3]));
                }
                sq = qsum(sq);
                if (fq == 0) atomicAdd(ss + r, sq);
            }
        }
    }
};
struct EpiUp {
    static constexpr bool PERM = true;
    const float* ss; bf16_t* H;
    __device__ __forceinline__ void operator()(const f32x4 (&acc)[2][2][4][2], const Unit& u, int wr, int wc, int fr, int fq) const {
        float rs[8];
#pragma unroll
        for (int i = 0; i < 8; ++i) rs[i] = ss[u.pm * 256 + (i >> 2) * 128 + wr * 64 + (i & 3) * 16 + fr];
#pragma unroll
        for (int i = 0; i < 8; ++i) rs[i] = rsqrtf(rs[i] * (1.0f / DM) + EPS);
#pragma unroll
        for (int ai = 0; ai < 2; ++ai)
#pragma unroll
            for (int m = 0; m < 4; ++m) {
                const int r = u.pm * 256 + ai * 128 + wr * 64 + m * 16 + fr;
                const float rstd = rs[ai * 4 + m];
#pragma unroll
                for (int bj = 0; bj < 2; ++bj) {
                    f32x4 v0 = acc[ai][bj][m][0] * rstd, v1 = acc[ai][bj][m][1] * rstd;
#pragma unroll
                    for (int e = 0; e < 4; ++e) { const float a = fmaxf(v0[e], 0.f), b = fmaxf(v1[e], 0.f); v0[e] = a * a; v1[e] = b * b; }
                    *(u32x4*)(H + (size_t)r * FF + u.pn * 256 + bj * 128 + wc * 32 + 8 * fq) = pack8(v0, v1);
                }
            }
    }
};

constexpr int KB_BYTES = 17408, VB_BYTES = 18432, BUF_BYTES = KB_BYTES + VB_BYTES, KT_PITCH = 272, VT_PITCH = 144;
constexpr int IMP_OFF = 2 * BUF_BYTES, SELM_OFF = IMP_OFF + 65536;
constexpr float NEG_BIG = -1.0e30f;

struct StageRegs { u32x4 k[2], v[2]; };
template <bool DOK, bool DOV>
__device__ __forceinline__ void stage_load(StageRegs& R, const bf16_t* Kg, const bf16_t* VTg, int vpitch, int key0, int tid) {
#pragma unroll
    for (int i = 0; i < 2; ++i) {
        const int idx = tid + i * 512;
        if (DOK) R.k[i] = *(const u32x4*)(Kg + (size_t)(key0 + (idx >> 4)) * 128 + (idx & 15) * 8);
        if (DOV) R.v[i] = *(const u32x4*)(VTg + (size_t)(idx >> 3) * vpitch + key0 + (idx & 7) * 8);
    }
}
template <bool DOK, bool DOV>
__device__ __forceinline__ void stage_store(const StageRegs& R, LAS unsigned char* buf, int tid) {
#pragma unroll
    for (int i = 0; i < 2; ++i) {
        const int idx = tid + i * 512;
        if (DOK) *(LAS u32x4*)(buf + (idx >> 4) * KT_PITCH + (idx & 15) * 16) = R.k[i];
        if (DOV) *(LAS u32x4*)(buf + KB_BYTES + (idx >> 3) * VT_PITCH + (idx & 7) * 16) = R.v[i];
    }
}
__device__ __forceinline__ void qk_tile2(f32x4 (&s)[2][4], const bf16x8 (&qf)[2][4], const LAS unsigned char* buf, int ql, int g, float init0 = 0.f, float init1 = 0.f) {
#pragma unroll
    for (int sub = 0; sub < 4; ++sub) { s[0][sub] = (f32x4){init0, init0, init0, init0}; s[1][sub] = (f32x4){init1, init1, init1, init1}; }
#pragma unroll
    for (int kc = 0; kc < 4; ++kc) {
        bf16x8 kf[4];
#pragma unroll
        for (int sub = 0; sub < 4; ++sub) kf[sub] = *(const LAS bf16x8*)(buf + (16 * sub + ql) * KT_PITCH + kc * 64 + g * 16);
#pragma unroll
        for (int sub = 0; sub < 4; ++sub) {
            s[0][sub] = __builtin_amdgcn_mfma_f32_16x16x32_bf16(kf[sub], qf[0][kc], s[0][sub], 0, 0, 0);
            s[1][sub] = __builtin_amdgcn_mfma_f32_16x16x32_bf16(kf[sub], qf[1][kc], s[1][sub], 0, 0, 0);
        }
        if (kc & 1) asm volatile("" ::: "memory");
    }
}
__device__ __forceinline__ void pv_tile2(f32x4 (&o)[2][8], const u32x4 (&pk)[2][2], const LAS unsigned char* buf, int ql, int g) {
#pragma unroll
    for (int ch = 0; ch < 2; ++ch) {
        const bf16x8 pf0 = __builtin_bit_cast(bf16x8, pk[0][ch]), pf1 = __builtin_bit_cast(bf16x8, pk[1][ch]);
#pragma unroll
        for (int dt = 0; dt < 8; ++dt) {
            const LAS unsigned char* rowp = buf + KB_BYTES + (16 * dt + ql) * VT_PITCH + (32 * ch + 4 * g) * 2;
            const u32x2 lo = *(const LAS u32x2*)(rowp), hi = *(const LAS u32x2*)(rowp + 32);
            const bf16x8 vf = __builtin_bit_cast(bf16x8, (u32x4){lo.x, lo.y, hi.x, hi.y});
            o[0][dt] = __builtin_amdgcn_mfma_f32_16x16x32_bf16(vf, pf0, o[0][dt], 0, 0, 0);
            o[1][dt] = __builtin_amdgcn_mfma_f32_16x16x32_bf16(vf, pf1, o[1][dt], 0, 0, 0);
            if ((dt & 3) == 3) asm volatile("" ::: "memory");
        }
    }
}
template <bool FULL>
__device__ __forceinline__ void softmax_tile(f32x4 (&s)[4], f32x4 (&o)[8], u32x4 (&pk)[2], float& mrun, float& lsum, bool take, int rel, int lowrel) {
    float mx = NEG_BIG;
    if (FULL) {
#pragma unroll
        for (int sub = 0; sub < 4; ++sub) { float m2; asm("v_max3_f32 %0, %1, %2, %3" : "=v"(m2) : "v"(mx), "v"(s[sub][0]), "v"(s[sub][1])); asm("v_max3_f32 %0, %1, %2, %3" : "=v"(mx) : "v"(m2), "v"(s[sub][2]), "v"(s[sub][3])); }
        mx = take ? mx : NEG_BIG;
    } else {
#pragma unroll
        for (int sub = 0; sub < 4; ++sub)
#pragma unroll
            for (int e = 0; e < 4; ++e) { const int kk = sub * 16 + e; const bool ok = take && kk <= rel && kk > lowrel; s[sub][e] = ok ? s[sub][e] : NEG_BIG; }
#pragma unroll
        for (int sub = 0; sub < 4; ++sub) { float m2; asm("v_max3_f32 %0, %1, %2, %3" : "=v"(m2) : "v"(mx), "v"(s[sub][0]), "v"(s[sub][1])); asm("v_max3_f32 %0, %1, %2, %3" : "=v"(mx) : "v"(m2), "v"(s[sub][2]), "v"(s[sub][3])); }
    }
    mx = qmax(mx);
    const float mnew = fmaxf(mrun, mx), alpha = __builtin_amdgcn_exp2f(mrun - mnew);
    mrun = mnew;
    float ps = 0.f;
    if (FULL) {
        const float c = take ? -mnew : -__builtin_inff();
#pragma unroll
        for (int sub = 0; sub < 4; ++sub)
#pragma unroll
            for (int e = 0; e < 4; ++e) { const float pv = __builtin_amdgcn_exp2f(s[sub][e] + c); s[sub][e] = pv; ps += pv; }
    } else {
#pragma unroll
        for (int sub = 0; sub < 4; ++sub)
#pragma unroll
            for (int e = 0; e < 4; ++e) { const float pv = (s[sub][e] > -1.0e29f) ? __builtin_amdgcn_exp2f(s[sub][e] - mnew) : 0.f; s[sub][e] = pv; ps += pv; }
    }
    lsum = lsum * alpha + ps;
#pragma unroll
    for (int dt = 0; dt < 8; ++dt) o[dt] = o[dt] * alpha;
    pk[0] = pack8(s[0], s[1]); pk[1] = pack8(s[2], s[3]);
}

__device__ __forceinline__ float local_max16(const f32x4 (&sp)[4]) {
    float mx = sp[0][0];
#pragma unroll
    for (int sub = 0; sub < 4; ++sub) { float m2; asm("v_max3_f32 %0, %1, %2, %3" : "=v"(m2) : "v"(mx), "v"(sp[sub][0]), "v"(sp[sub][1])); asm("v_max3_f32 %0, %1, %2, %3" : "=v"(mx) : "v"(m2), "v"(sp[sub][2]), "v"(sp[sub][3])); }
    return mx;
}
constexpr float DEFER_THRESH = 10.0f;

template <int MODE, bool DEFER>
__device__ __forceinline__ void flash_step(int tile, int tile_hi, f32x4 (&o)[2][8], float (&lsum)[2], float (&mrun)[2], StageRegs& R, const bf16x8 (&qf)[2][4], const bf16_t* Kg, const bf16_t* VTg, int vpitch,
                                           const int (&t)[2], const unsigned long long (&selm)[2], LAS unsigned char* lds, int tid, int ql, int g) {
    const LAS unsigned char* buf = lds + (tile & 1) * BUF_BYTES;
    bool take[2] = {true, true};
    if (MODE == 1) { take[0] = ((selm[0] >> tile) & 1ull) != 0ull; take[1] = ((selm[1] >> tile) & 1ull) != 0ull; }
    f32x4 s[2][4];
    if (DEFER) qk_tile2(s, qf, buf, ql, g, take[0] ? -mrun[0] : -__builtin_inff(), take[1] ? -mrun[1] : -__builtin_inff());
    else qk_tile2(s, qf, buf, ql, g);
    if (tile < tile_hi) stage_load<true, true>(R, Kg, VTg, vpitch, (tile + 1) * 64, tid);
    u32x4 pk[2][2];
    if (DEFER) {
        float m0 = local_max16(s[0]), m1 = local_max16(s[1]);
        if (__any(m0 > DEFER_THRESH || m1 > DEFER_THRESH)) {
            m0 = fmaxf(qmax(m0), 0.f); m1 = fmaxf(qmax(m1), 0.f);
            const float a0 = __builtin_amdgcn_exp2f(-m0), a1 = __builtin_amdgcn_exp2f(-m1);
            mrun[0] += m0; mrun[1] += m1; lsum[0] *= a0; lsum[1] *= a1;
#pragma unroll
            for (int dt = 0; dt < 8; ++dt) { o[0][dt] = o[0][dt] * a0; o[1][dt] = o[1][dt] * a1; }
#pragma unroll
            for (int sub = 0; sub < 4; ++sub) { s[0][sub] = s[0][sub] - m0; s[1][sub] = s[1][sub] - m1; }
        }
#pragma unroll
        for (int gp = 0; gp < 2; ++gp) {
            float ps = 0.f;
#pragma unroll
            for (int sub = 0; sub < 4; ++sub)
#pragma unroll
                for (int e = 0; e < 4; ++e) { const float pv = __builtin_amdgcn_exp2f(s[gp][sub][e]); s[gp][sub][e] = pv; ps += pv; }
            lsum[gp] += ps;
            pk[gp][0] = pack8(s[gp][0], s[gp][1]); pk[gp][1] = pack8(s[gp][2], s[gp][3]);
        }
    } else {
#pragma unroll
        for (int gp = 0; gp < 2; ++gp) {
            int rel, lowrel = -1000000;
            if (MODE == 0) rel = ((t[gp] - 31) >> 4) - tile * 64 - 4 * g;
            else { rel = t[gp] - tile * 64 - 4 * g; if (MODE == 2) lowrel = rel - 512; }
            softmax_tile<false>(s[gp], o[gp], pk[gp], mrun[gp], lsum[gp], take[gp], rel, lowrel);
        }
    }
    pv_tile2(o, pk, buf, ql, g);
    if (tile < tile_hi) stage_store<true, true>(R, lds + ((tile + 1) & 1) * BUF_BYTES, tid);
    __syncthreads();
}

template <int MODE>
__device__ __forceinline__ void flash_range(f32x4 (&o)[2][8], float (&lsum)[2], float (&mfin)[2], const bf16x8 (&qf)[2][4], const bf16_t* Kg, const bf16_t* VTg, int vpitch,
                                            int tile_lo, int tile_hi, int tb, const int (&t)[2], const unsigned long long (&selm)[2], LAS unsigned char* lds, int tid, int ql, int g) {
    float mrun[2] = {NEG_BIG, NEG_BIG}; lsum[0] = 0.f; lsum[1] = 0.f;
#pragma unroll
    for (int gp = 0; gp < 2; ++gp)
#pragma unroll
        for (int dt = 0; dt < 8; ++dt) o[gp][dt] = (f32x4){0.f, 0.f, 0.f, 0.f};
    StageRegs R; stage_load<true, true>(R, Kg, VTg, vpitch, tile_lo * 64, tid);
    __syncthreads();
    stage_store<true, true>(R, lds + (tile_lo & 1) * BUF_BYTES, tid);
    __syncthreads();
    int tile = tile_lo;
    if (MODE == 0) {
#pragma unroll 1
        for (; tile <= tile_hi; ++tile) flash_step<MODE, false>(tile, tile_hi, o, lsum, mrun, R, qf, Kg, VTg, vpitch, t, selm, lds, tid, ql, g);
    } else {
        const int d_lo = tile_lo + (MODE == 1 ? 1 : 2);
#pragma unroll 1
        for (; tile <= tile_hi && tile < d_lo; ++tile) flash_step<MODE, false>(tile, tile_hi, o, lsum, mrun, R, qf, Kg, VTg, vpitch, t, selm, lds, tid, ql, g);
#pragma unroll 1
        for (; tile < tile_hi; ++tile) flash_step<MODE, true>(tile, tile_hi, o, lsum, mrun, R, qf, Kg, VTg, vpitch, t, selm, lds, tid, ql, g);
#pragma unroll 1
        for (; tile <= tile_hi; ++tile) flash_step<MODE, false>(tile, tile_hi, o, lsum, mrun, R, qf, Kg, VTg, vpitch, t, selm, lds, tid, ql, g);
    }
    lsum[0] = qsum(lsum[0]); lsum[1] = qsum(lsum[1]); mfin[0] = mrun[0]; mfin[1] = mrun[1];
}

__device__ __forceinline__ void attn_item(const bf16_t* Q, const bf16_t* KV, const bf16_t* KC, const bf16_t* VCT, const float* NG, bf16_t* OATT,
                                          int bg, int tb, LAS unsigned char* lds) {
    int tid = threadIdx.x; asm volatile("" : "+v"(tid));
    const int w = __builtin_amdgcn_readfirstlane(tid >> 6), lane = tid & 63, r = w >> 1, qh = w & 1; int ql = lane & 15, g = lane >> 4;
    asm volatile("" : "+v"(ql), "+v"(g));
    const int b = bg >> 2, gk = bg & 3, h = gk * 4 + r;
    int qq[2], t[2], row[2];
    bf16x8 qf[2][4];
#pragma unroll
    for (int gp = 0; gp < 2; ++gp) {
        qq[gp] = 32 * qh + 16 * gp + ql; t[gp] = 64 * tb + qq[gp]; row[gp] = b * SEQ + t[gp];
#pragma unroll
        for (int kc = 0; kc < 4; ++kc) qf[gp][kc] = *(const bf16x8*)(Q + (size_t)row[gp] * DM + h * 128 + kc * 32 + g * 8);
    }
    if (tb >= 16) { LAS u32x4* z = (LAS u32x4*)(lds + IMP_OFF);
#pragma unroll
      for (int i = 0; i < 8; ++i) z[tid + i * 512] = (u32x4){0u, 0u, 0u, 0u}; }
    const unsigned long long nosel[2] = {0ull, 0ull};
    const bf16_t* KCg = KC + (size_t)bg * 256 * 128; const bf16_t* VCg = VCT + (size_t)bg * 128 * 256;
    const int cmp_hi = (4 * tb + 2) >> 6;
    float mc[2], invc[2];
    {
        f32x4 o[2][8]; float l[2];
        flash_range<0>(o, l, mc, qf, KCg, VCg, 256, 0, cmp_hi, tb, t, nosel, lds, tid, ql, g);
#pragma unroll
        for (int gp = 0; gp < 2; ++gp) {
            invc[gp] = l[gp] > 0.f ? 1.0f / l[gp] : 0.f;
            const float sc = NG[(size_t)row[gp] * 48 + h * 3 + 0] * invc[gp];
#pragma unroll
            for (int dt = 0; dt < 8; ++dt) { const f32x4 v = o[gp][dt] * sc; u32x2 wv; wv.x = cvt_pk_bf16(v[0], v[1]); wv.y = cvt_pk_bf16(v[2], v[3]);
                *(u32x2*)(OATT + (size_t)row[gp] * DM + h * 128 + dt * 16 + 4 * g) = wv; }
        }
    }
    unsigned long long selm[2] = {~0ull, ~0ull};
    if (tb >= 16) {
    {
        StageRegs R; stage_load<true, false>(R, KCg, VCg, 256, 0, tid);
        stage_store<true, false>(R, lds, tid);
        __syncthreads();
#pragma unroll 1
        for (int tile = 0; tile <= cmp_hi; ++tile) {
            const LAS unsigned char* buf = lds + (tile & 1) * BUF_BYTES;
            if (tile < cmp_hi) stage_load<true, false>(R, KCg, VCg, 256, (tile + 1) * 64, tid);
            f32x4 s[2][4]; qk_tile2(s, qf, buf, ql, g);
#pragma unroll
            for (int gp = 0; gp < 2; ++gp) {
                const int rel = ((t[gp] - 31) >> 4) - tile * 64 - 4 * g;
                LAS float* imp = (LAS float*)(lds + IMP_OFF) + (r * 64 + qq[gp]) * 64 + 16 * tile + g;
                float carry[4];
#pragma unroll
                for (int sub = 0; sub < 4; ++sub) {
                    f32x4 p4;
#pragma unroll
                    for (int e = 0; e < 4; ++e) p4[e] = (sub * 16 + e <= rel) ? __builtin_amdgcn_exp2f(s[gp][sub][e] - mc[gp]) * invc[gp] : 0.f;
                    atomicAdd((float*)(imp + 4 * sub), (p4[0] + p4[1]) + (p4[2] + 0.5f * p4[3]));
                    carry[sub] = 0.5f * p4[3];
                }
#pragma unroll
                for (int sub = 0; sub < 4; ++sub) if (16 * tile + 4 * sub + g + 1 < 64) atomicAdd((float*)(imp + 4 * sub + 1), carry[sub]);
            }
            if (tile < cmp_hi) stage_store<true, false>(R, lds + ((tile + 1) & 1) * BUF_BYTES, tid);
            __syncthreads();
        }
    }
    {
#pragma unroll 1
        for (int i = 0; i < 8; ++i) {
            const int q2 = 8 * w + i;
            const LAS float* ip = (const LAS float*)(lds + IMP_OFF) + q2 * 64 + lane;
            float v = ((ip[0] + ip[64 * 64]) + ip[2 * 64 * 64]) + ip[3 * 64 * 64];
            const bool valid = lane <= tb, forced = (lane == 0) || (lane == tb) || (lane == tb - 1);
            v = valid ? (forced ? __builtin_inff() : v) : -__builtin_inff();
            int rank = 0;
#pragma unroll 8
            for (int mm = 0; mm < 64; ++mm) { const float vm = __builtin_bit_cast(float, __builtin_amdgcn_readlane(__builtin_bit_cast(int, v), mm)); rank += (vm > v || (vm == v && mm < lane)) ? 1 : 0; }
            const unsigned long long mask = __ballot(rank < 16);
            if (lane == 0) *(LAS unsigned long long*)(lds + SELM_OFF + q2 * 8) = mask;
        }
    }
    __syncthreads();
    selm[0] = *(const LAS unsigned long long*)(lds + SELM_OFF + qq[0] * 8); selm[1] = *(const LAS unsigned long long*)(lds + SELM_OFF + qq[1] * 8);
    }
    {
        f32x4 o[2][8]; float l[2], mf[2];
        flash_range<1>(o, l, mf, qf, KV + 2 * KVJ + (size_t)bg * SEQ * 128, KV + 3 * KVJ + (size_t)bg * 128 * SEQ, SEQ, 0, tb, tb, t, selm, lds, tid, ql, g);
#pragma unroll
        for (int gp = 0; gp < 2; ++gp) {
            const float sc = NG[(size_t)row[gp] * 48 + h * 3 + 1] / l[gp];
#pragma unroll
            for (int dt = 0; dt < 8; ++dt) {
                u32x2* dst = (u32x2*)(OATT + (size_t)row[gp] * DM + h * 128 + dt * 16 + 4 * g); const u32x2 pr = *dst;
                f32x4 v = o[gp][dt] * sc; v[0] += bflo(pr.x); v[1] += bfhi(pr.x); v[2] += bflo(pr.y); v[3] += bfhi(pr.y);
                u32x2 wv; wv.x = cvt_pk_bf16(v[0], v[1]); wv.y = cvt_pk_bf16(v[2], v[3]); *dst = wv;
            }
        }
    }
    {
        f32x4 o[2][8]; float l[2], mf[2];
        const int tlo = tb > 8 ? tb - 8 : 0;
        flash_range<2>(o, l, mf, qf, KV + 4 * KVJ + (size_t)bg * SEQ * 128, KV + 5 * KVJ + (size_t)bg * 128 * SEQ, SEQ, tlo, tb, tb, t, nosel, lds, tid, ql, g);
#pragma unroll
        for (int gp = 0; gp < 2; ++gp) {
            const float sc = NG[(size_t)row[gp] * 48 + h * 3 + 2] / l[gp];
#pragma unroll
            for (int dt = 0; dt < 8; ++dt) {
                u32x2* dst = (u32x2*)(OATT + (size_t)row[gp] * DM + h * 128 + dt * 16 + 4 * g); const u32x2 pr = *dst;
                f32x4 v = o[gp][dt] * sc; v[0] += bflo(pr.x); v[1] += bfhi(pr.x); v[2] += bflo(pr.y); v[3] += bfhi(pr.y);
                u32x2 wv; wv.x = cvt_pk_bf16(v[0], v[1]); wv.y = cvt_pk_bf16(v[2], v[3]); *dst = wv;
            }
        }
    }
}

enum { MAP_ID = 0, MAP_IN = 1 };
__device__ __forceinline__ int map_in(int n) {
    if (n < 2048) return (n & ~127) + ropeperm(n & 127);
    if (n < 5120) { const int rel = n - 2048, j = rel >> 9, p = rel & 127; const int d = (j == 2 || j == 4) ? ropeperm(p) : p; return 2048 + (rel & ~127) + d; }
    if (n < 11264) return 5168 + (n - 5120);
    if (n < 15360) return 11312 + (n - 11264);
    if (n < 15408) return 5120 + (n - 15360);
    return -1;
}
__device__ __forceinline__ void transpose_item(const float* W, int K, int Nsrc, bf16_t* WT, int Ndst, const float* gain, int maptype, LAS float* scr, int item, int lane) {
    const int nblk = Ndst / 64, kb = item / nblk, nb = item % nblk, k0 = 64 * kb, n0 = 64 * nb;
    const int nd = n0 + lane; const int src = (maptype == MAP_IN) ? map_in(nd) : nd;
    const float* wp = W + (size_t)k0 * Nsrc + (src >= 0 ? src : 0);
#pragma unroll
    for (int h = 0; h < 2; ++h) {
        float v[32];
#pragma unroll
        for (int i = 0; i < 32; ++i) v[i] = wp[(size_t)(32 * h + i) * Nsrc];
#pragma unroll
        for (int i = 0; i < 32; ++i) { float x = (src >= 0) ? v[i] : 0.f; if (gain) x *= gain[k0 + 32 * h + i]; scr[(32 * h + i) * 65 + lane] = x; }
    }
    asm volatile("s_waitcnt lgkmcnt(0)" ::: "memory");
    const int cidx = lane & 7;
#pragma unroll
    for (int j = 0; j < 8; ++j) { const int n = (lane >> 3) + 8 * j; const LAS float* s = scr + (8 * cidx) * 65 + n;
        u32x4 o; o.x = cvt_pk_bf16(s[0 * 65], s[1 * 65]); o.y = cvt_pk_bf16(s[2 * 65], s[3 * 65]); o.z = cvt_pk_bf16(s[4 * 65], s[5 * 65]); o.w = cvt_pk_bf16(s[6 * 65], s[7 * 65]);
        *(u32x4*)(WT + (size_t)(n0 + n) * K + k0 + 8 * cidx) = o; }
    asm volatile("s_waitcnt lgkmcnt(0)" ::: "memory");
}
__device__ __forceinline__ float wave_sum(float v) {
#pragma unroll
    for (int o = 1; o < 64; o <<= 1) v += __shfl_xor(v, o);
    return v;
}

__device__ __forceinline__ void prep_phase(const Params& P, LAS unsigned char* lds) {
    int tid = threadIdx.x; asm volatile("" : "+v"(tid));
    const int wave = tid >> 6, lane = tid & 63;
    const int gw = blockIdx.x * 8 + wave, NGW = gridDim.x * 8;
    const int gt = blockIdx.x * 512 + tid, NGT = gridDim.x * 512;
    unsigned char* ws = P.ws;
    LAS float* scr = (LAS float*)(lds + wave * 16640);
    constexpr int I_IN = (DM / 64) * (NIN / 64), I_SQ = (DM / 64) * (DM / 64), I_UP = (DM / 64) * (FF / 64), I_DN = (FF / 64) * (DM / 64), I_C1 = (4096 / 64) * (256 / 64);
    constexpr int I_LAYER = I_IN + 3 * I_SQ + I_UP + I_DN + 2 * I_C1;
    for (int it = gw; it < DEPTH * I_LAYER; it += NGW) {
        const int L = it / I_LAYER; int r = it % I_LAYER;
        if (r < I_IN) { transpose_item(P.in[2] + (size_t)L * DM * IN_COLS, DM, IN_COLS, (bf16_t*)(ws + WS_WIN) + (size_t)L * NIN * DM, NIN, P.in[1] + L * DM, MAP_IN, scr, r, lane); continue; } r -= I_IN;
        if (r < I_SQ) { transpose_item(P.in[10] + (size_t)L * DM * DM, DM, DM, (bf16_t*)(ws + WS_WAP) + (size_t)L * DM * DM, DM, nullptr, MAP_ID, scr, r, lane); continue; } r -= I_SQ;
        if (r < I_SQ) { transpose_item(P.in[11] + (size_t)L * DM * DM, DM, DM, (bf16_t*)(ws + WS_WCO) + (size_t)L * DM * DM, DM, nullptr, MAP_ID, scr, r, lane); continue; } r -= I_SQ;
        if (r < I_SQ) { transpose_item(P.in[12] + (size_t)L * DM * DM, DM, DM, (bf16_t*)(ws + WS_WO) + (size_t)L * DM * DM, DM, nullptr, MAP_ID, scr, r, lane); continue; } r -= I_SQ;
        if (r < I_UP) { transpose_item(P.in[14] + (size_t)L * DM * FF, DM, FF, (bf16_t*)(ws + WS_WUP) + (size_t)L * FF * DM, FF, P.in[13] + L * DM, MAP_ID, scr, r, lane); continue; } r -= I_UP;
        if (r < I_DN) { transpose_item(P.in[15] + (size_t)L * FF * DM, FF, DM, (bf16_t*)(ws + WS_WDN) + (size_t)L * DM * FF, DM, nullptr, MAP_ID, scr, r, lane); continue; } r -= I_DN;
        if (r < I_C1) { transpose_item(P.in[4] + (size_t)L * 4096 * 256, 4096, 256, (bf16_t*)(ws + WS_CW1) + (size_t)(L * 2 + 0) * 256 * 4096, 256, nullptr, MAP_ID, scr, r, lane); continue; } r -= I_C1;
        transpose_item(P.in[7] + (size_t)L * 4096 * 256, 4096, 256, (bf16_t*)(ws + WS_CW1) + (size_t)(L * 2 + 1) * 256 * 4096, 256, nullptr, MAP_ID, scr, r, lane);
    }
    for (int i = gt; i < DEPTH * 256 * 512; i += NGT) {
        const int L = i / (256 * 512), o = (i >> 9) & 255, k = i & 511; float v = 0.f;
        if (o < 128) { if (k < 256) v = P.in[5][(size_t)L * 256 * 128 + k * 128 + ropeperm(o)]; }
        else { if (k >= 256) v = P.in[8][(size_t)L * 256 * 128 + (k - 256) * 128 + (o - 128)]; }
        ((bf16_t*)(ws + WS_CW2))[i] = (bf16_t)(cvt_pk_bf16(v, 0.f) & 0xffff);
    }
    for (int it = gw; it < DEPTH * 2 * 256; it += NGW) {
        const int L = it >> 9, kv = (it >> 8) & 1, j = it & 255;
        const float* pe = P.in[kv ? 6 : 3] + (size_t)L * 4096; const float* w1 = P.in[kv ? 7 : 4] + (size_t)L * 4096 * 256;
        float s = 0.f; for (int i = lane; i < 4096; i += 64) s += pe[i] * w1[(size_t)i * 256 + j];
        s = wave_sum(s); if (lane == 0) ((float*)(ws + WS_CB))[it] = s;
    }
    for (int i = gt; i < SEQ * 64; i += NGT) {
        const int pos = i >> 6, f = i & 63;
        const float invf = expf(-9.210340371976184f * (float)f / 64.0f);
        const float ang = (float)pos * invf;
        const double rev = (double)ang * 0.15915494309189535; const float fr = (float)(rev - rint(rev));
        ((float*)(ws + WS_ROPE))[i] = __builtin_amdgcn_cosf(fr); ((float*)(ws + WS_ROPE))[SEQ * 64 + i] = __builtin_amdgcn_sinf(fr);
    }
    for (int m = gw; m < T; m += NGW) {
        const f32x4* xr = (const f32x4*)(P.in[0] + (size_t)m * DM) + lane; float s = 0.f;
        u32x2* o8 = (u32x2*)((bf16_t*)(ws + WS_XB) + (size_t)m * DM) + lane;
#pragma unroll
        for (int j = 0; j < 8; ++j) { const f32x4 v = xr[64 * j]; s += (v[0] * v[0] + v[1] * v[1]) + (v[2] * v[2] + v[3] * v[3]); u32x2 w; w.x = cvt_pk_bf16(v[0], v[1]); w.y = cvt_pk_bf16(v[2], v[3]); o8[64 * j] = w; }
        s = wave_sum(s); if (lane == 0) ((float*)(ws + WS_SS))[m] = s;
    }
    for (int i = gt; i < 4 * T; i += NGT) __hip_atomic_store((float*)(ws + WS_SS) + T + i, 0.f, __ATOMIC_RELAXED, __HIP_MEMORY_SCOPE_AGENT);
}

__device__ __forceinline__ void conv_rows(const bf16_t* __restrict__ CV, const float* __restrict__ cw, bf16_t* __restrict__ VB, int gw, int NGW, int lane) {
    for (int item = gw; item < T / 4; item += NGW) {
        const int blk = item >> 1, hc = (item & 1) * 1024, row0 = blk * 8, s0 = row0 & (SEQ - 1);
        float u1[16], u2[16]; float zv = 0.f; asm volatile("" : "+v"(zv));
#pragma unroll
        for (int i = 0; i < 16; ++i) { u1[i] = zv; u2[i] = zv; }
        if (s0 != 0) {
            const bf16_t* rm = CV + (size_t)(row0 - 1) * 6144 + hc;
#pragma unroll
            for (int it = 0; it < 2; ++it) {
                const int ch = it * 512 + lane * 8;
                const u32x4 xa = *(const u32x4*)(rm + ch), ca = *(const u32x4*)(rm + 4096 + ch), xb = *(const u32x4*)(rm - 6144 + ch), cb = *(const u32x4*)(rm - 6144 + 4096 + ch);
#pragma unroll
                for (int e = 0; e < 4; ++e) { u1[it * 8 + 2 * e] = bflo(xa[e]) * bflo(ca[e]); u1[it * 8 + 2 * e + 1] = bfhi(xa[e]) * bfhi(ca[e]);
                                              u2[it * 8 + 2 * e] = bflo(xb[e]) * bflo(cb[e]); u2[it * 8 + 2 * e + 1] = bfhi(xb[e]) * bfhi(cb[e]); }
            }
        }
        float w0[16], w1[16], w2[16];
#pragma unroll
        for (int it = 0; it < 2; ++it)
#pragma unroll
            for (int e = 0; e < 8; ++e) { const int c = hc + it * 512 + lane * 8 + e; w0[it * 8 + e] = cw[c]; w1[it * 8 + e] = cw[DM + c]; w2[it * 8 + e] = cw[2 * DM + c]; }
#pragma unroll 1
        for (int r = 0; r < 8; ++r) {
            const bf16_t* r0 = CV + (size_t)(row0 + r) * 6144 + hc;
            u32x4 x0[2], gb[2], c0[2];
#pragma unroll
            for (int it = 0; it < 2; ++it) { const int ch = it * 512 + lane * 8; x0[it] = *(const u32x4*)(r0 + ch); gb[it] = *(const u32x4*)(r0 + 2048 + ch); c0[it] = *(const u32x4*)(r0 + 4096 + ch); }
#pragma unroll
            for (int it = 0; it < 2; ++it) {
                float res[8];
#pragma unroll
                for (int e = 0; e < 4; ++e) {
                    const int ia = it * 8 + 2 * e, ib = ia + 1;
                    const float ua = bflo(x0[it][e]) * bflo(c0[it][e]), ub = bfhi(x0[it][e]) * bfhi(c0[it][e]);
                    res[2 * e] = bflo(gb[it][e]) * (w0[ia] * u2[ia] + w1[ia] * u1[ia] + w2[ia] * ua);
                    res[2 * e + 1] = bfhi(gb[it][e]) * (w0[ib] * u2[ib] + w1[ib] * u1[ib] + w2[ib] * ub);
                    u2[ia] = u1[ia]; u1[ia] = ua; u2[ib] = u1[ib]; u1[ib] = ub;
                }
                u32x4 o; o.x = cvt_pk_bf16(res[0], res[1]); o.y = cvt_pk_bf16(res[2], res[3]); o.z = cvt_pk_bf16(res[4], res[5]); o.w = cvt_pk_bf16(res[6], res[7]);
                *(u32x4*)(VB + (size_t)(row0 + r) * DM + hc + it * 512 + lane * 8) = o;
            }
        }
    }
}

#define XB_TMO      128
#define XB_XCNT(j)  (256  + 64 * (j))
#define XB_XSUB(j)  (1280 + 64 * (j))
#define XB_XGEN(j)  (2304 + 64 * (j))
#define XB_TOP      3328
#define XB_TOPGEN   3392
#define XCD_BAR_WORDS 3456
#define XB_SPIN_CAP (1u << 22)
__device__ __forceinline__ unsigned xb_ld(unsigned* p)              { return __hip_atomic_load(p, __ATOMIC_RELAXED, __HIP_MEMORY_SCOPE_AGENT); }
__device__ __forceinline__ unsigned xb_add(unsigned* p, unsigned v) { return __hip_atomic_fetch_add(p, v, __ATOMIC_RELAXED, __HIP_MEMORY_SCOPE_AGENT); }
__device__ __forceinline__ unsigned xb_xcc_id() { return (unsigned)__builtin_amdgcn_s_getreg((3 << 11) | 20) & 0xFu; }
#define XB_SPIN(cond, bar) do { unsigned _sp = 0; while (cond) { __builtin_amdgcn_s_sleep(1); \
    if ((++_sp & 255u) == 0u) { if (xb_ld(&(bar)[XB_TMO])) break; if (_sp > XB_SPIN_CAP) { atomicAdd(&(bar)[XB_TMO], 1u); break; } } } } while (0)
struct XcdBarrier { unsigned* bar; unsigned x; volatile LAS unsigned* st; };
__device__ __forceinline__ XcdBarrier xcd_barrier_post(unsigned* bar, volatile LAS unsigned* st) {
    XcdBarrier b; b.bar = bar; b.x = xb_xcc_id(); b.st = st;
    if (threadIdx.x == 0) (void)xb_add(&bar[XB_XCNT(b.x)], 1u);
    return b;
}
__device__ __forceinline__ void xcd_barrier_complete(unsigned* bar, unsigned x, unsigned& nloc, unsigned& nx) {
    const unsigned G = gridDim.x * gridDim.y * gridDim.z;
    unsigned sum, cnt, mine, sp = 0u;
    for (;;) {
        sum = 0u; cnt = 0u; mine = 0u;
#pragma unroll
        for (unsigned j = 0; j < 16; ++j) { const unsigned c = xb_ld(&bar[XB_XCNT(j)]); sum += c; cnt += (c > 0u) ? 1u : 0u; mine = (j == x) ? c : mine; }
        if (sum == G) break;
        __builtin_amdgcn_s_sleep(1);
        if ((++sp & 255u) == 0u) { if (xb_ld(&bar[XB_TMO])) break; if (sp > XB_SPIN_CAP) { atomicAdd(&bar[XB_TMO], 1u); break; } }
    }
    nloc = mine > 0u ? mine : 1u; nx = cnt > 0u ? cnt : 1u;
}
__device__ __forceinline__ void xcd_barrier(const XcdBarrier& b) {
    asm volatile("s_waitcnt vmcnt(0)" ::: "memory");
    __syncthreads();
    if (threadIdx.x == 0) {
        unsigned* bar = b.bar;
        __builtin_amdgcn_s_waitcnt(0);
        unsigned nloc = b.st[0], nx = b.st[1];
        if (nloc == 0u) { xcd_barrier_complete(bar, b.x, nloc, nx); b.st[0] = nloc; b.st[1] = nx; }
        const unsigned old = xb_add(&bar[XB_XSUB(b.x)], 1u);
        const unsigned gen = old / nloc;
        if (old + 1u == (gen + 1u) * nloc) {
            __builtin_amdgcn_fence(__ATOMIC_RELEASE, "agent");
            asm volatile("s_waitcnt vmcnt(0)" ::: "memory");
            const unsigned og = xb_add(&bar[XB_TOP], 1u);
            const unsigned tg = og / nx;
            if (og + 1u == (tg + 1u) * nx) xb_add(&bar[XB_TOPGEN], 1u);
            else XB_SPIN(xb_ld(&bar[XB_TOPGEN]) == tg, bar);
            __builtin_amdgcn_fence(__ATOMIC_ACQUIRE, "agent");
            xb_add(&bar[XB_XGEN(b.x)], 1u);
            asm volatile("s_waitcnt vmcnt(0)" ::: "memory");
        } else {
            XB_SPIN(xb_ld(&bar[XB_XGEN(b.x)]) == gen, bar);
            __builtin_amdgcn_fence(__ATOMIC_ACQUIRE, "agent");
            asm volatile("s_waitcnt vmcnt(0)" ::: "memory");
        }
    }
    __syncthreads();
}

constexpr int LDS_BYTES = 139264;
constexpr int NPH = 1 + 11 * DEPTH + 1;

typedef const __attribute__((address_space(4))) Params* KParams;
__device__ __forceinline__ KParams kparams() { KParams p = (KParams)__builtin_amdgcn_kernarg_segment_ptr(); asm volatile("" : "+s"(p)); return p; }

__global__ void __launch_bounds__(512, 2) nsa_fwd(Params P_unused) {
    extern __shared__ __attribute__((aligned(16))) unsigned char lds_raw[];
    LAS unsigned char* lds = (LAS unsigned char*)lds_raw;
    const int G = gridDim.x;
    int ph = 0;
    int lo, hi, coop; { KParams kp = kparams(); lo = kp->lo; hi = kp->hi; coop = kp->coop; }
    bool bar_up = false; XcdBarrier xbar; xbar.bar = nullptr; xbar.x = 0; xbar.st = nullptr;
    if (coop) {
        if (threadIdx.x < 4) ((volatile LAS unsigned*)(lds + LDS_BYTES - 16))[threadIdx.x] = 0u;
        if (blockIdx.x == 0) { unsigned* bw = (unsigned*)(kparams()->ws + WS_BAR); for (int i = threadIdx.x; i < XCD_BAR_WORDS; i += 512) bw[i] = 0u; }
        __syncthreads();
    }
#define PHASE_BEGIN if (ph >= lo && ph < hi) { KParams kp = kparams(); unsigned char* ws = kp->ws; (void)ws; int tidp = threadIdx.x; asm volatile("" : "+v"(tidp)); int bid = blockIdx.x; asm volatile("" : "+s"(bid)); (void)tidp; (void)bid;
#define PHASE_END   } ++ph; if (coop && ph > lo && ph < hi) { if (!bar_up) { cg::this_grid().sync(); xbar = xcd_barrier_post((unsigned*)(kparams()->ws + WS_BAR), (volatile LAS unsigned*)(lds + LDS_BYTES - 16)); bar_up = true; } else xcd_barrier(xbar); }
#define PHASE_END_NOBAR } ++ph; if (!coop && false) {}
#define PHASE_END_IF(cond) } ++ph; if ((cond) && coop && ph > lo && ph < hi) { xcd_barrier(xbar); }
#define WSP(T_, off) ((T_*)(ws + (off)))

    PHASE_BEGIN { Params Pl; for (int i = 0; i < 17; ++i) Pl.in[i] = kp->in[i]; Pl.out = kp->out; Pl.ws = ws; Pl.lo = 0; Pl.hi = 0; Pl.coop = 0; Pl.pad = 0; prep_phase(Pl, lds); } PHASE_END

#pragma unroll 1
    for (int L = 0; L < DEPTH; ++L) {
        PHASE_BEGIN {
            pg8::Gemm gm{WSP(const bf16_t, WS_XB), WSP(const bf16_t, WS_WIN) + (size_t)L * NIN * DM, T, NIN, DM, DM, DM}; pg8::StaticOrder S; S.init(T, NIN, G, bid);
            const float* ropec = WSP(const float, WS_ROPE);
            EpiIn E{WSP(const float, WS_SS) + (size_t)(2 * L) * T, ropec, ropec + SEQ * 64, WSP(bf16_t, WS_Q), WSP(bf16_t, WS_KV), WSP(bf16_t, WS_CV), WSP(bf16_t, WS_MG), WSP(float, WS_NG)};
            pg8::gemm_phase<EpiIn>(lds, gm, S, E);
        } PHASE_END
        PHASE_BEGIN {
#pragma unroll 1
            for (int u = bid; u < 256; u += G) {
                const int kv = u >> 7, pm = (u >> 3) & 15, ks = u & 7;
                pg8::Gemm gm{WSP(const bf16_t, WS_KV) + (size_t)kv * KVJ + (size_t)pm * 256 * 2048 + ks * 512, WSP(const bf16_t, WS_CW1) + (size_t)(L * 2 + kv) * 256 * 4096 + ks * 512, 256, 256, 512, 2048, 4096};
                pg8::StaticOrder S; S.init(256, 256, 1, 0);
                EpiC1S E{WSP(float, WS_XB) + (size_t)ks * 4096 * 512, pm * 256, kv * 256};
                pg8::gemm_phase<EpiC1S>(lds, gm, S, E);
            }
        } PHASE_END
        PHASE_BEGIN {
            const float* hp = WSP(const float, WS_XB); const float* cb = WSP(const float, WS_CB) + L * 512; bf16_t* hid = WSP(bf16_t, WS_HID);
            for (int i = bid * 512 + tidp; i < 4096 * 512 / 4; i += G * 512) {
                const int c = (i & 127) * 4;
                f32x4 v = *(const f32x4*)(cb + c);
#pragma unroll
                for (int ks = 0; ks < 8; ++ks) v = v + *(const f32x4*)(hp + (size_t)ks * 4096 * 512 + (size_t)i * 4);
#pragma unroll
                for (int e = 0; e < 4; ++e) v[e] = v[e] * sigmoidf_(v[e]);
                u32x2 w; w.x = cvt_pk_bf16(v[0], v[1]); w.y = cvt_pk_bf16(v[2], v[3]);
                *(u32x2*)(hid + (size_t)i * 4) = w;
            }
        } PHASE_END
        PHASE_BEGIN {
            pg8::Gemm gm{WSP(const bf16_t, WS_HID), WSP(const bf16_t, WS_CW2) + (size_t)L * 256 * 512, 4096, 256, 512, 512, 512}; pg8::StaticOrder S; S.init(4096, 256, G, bid);
            EpiC2 E{WSP(float, WS_C2T)};
            if (bid < 16 || G < 64) pg8::gemm_phase<EpiC2>(lds, gm, S, E);
            if (G == 256 && bid < 16) {
                const int bgu = (bid & 7) * 2 + (bid >> 3);
                asm volatile("s_waitcnt vmcnt(0)" ::: "memory"); __syncthreads();
                const float* ropec = WSP(const float, WS_ROPE);
                c2_finish_bg(WSP(const float, WS_C2T), ropec, ropec + SEQ * 64, WSP(bf16_t, WS_KC), WSP(bf16_t, WS_VCT), bgu, tidp);
            } else {
                const int skip = (G == 256) ? 16 : 0;
                conv_rows(WSP(const bf16_t, WS_CV), kp->in[9] + (size_t)L * 3 * DM, WSP(bf16_t, WS_VB), (bid - skip) * 8 + (tidp >> 6), (G - skip) * 8, tidp & 63);
            }
        } PHASE_END
        PHASE_BEGIN {
            if (G != 256) { const float* ropec = WSP(const float, WS_ROPE);
                c2_finish(WSP(const float, WS_C2T), ropec, ropec + SEQ * 64, WSP(bf16_t, WS_KC), WSP(bf16_t, WS_VCT), bid * 512 + tidp, G * 512); }
        } PHASE_END_IF(G != 256)
        PHASE_BEGIN {
            if (G == 256) {
                const int xcd = bid & 7, j = bid >> 3;
#pragma unroll 1
                for (int k = 0; k < 4; ++k) attn_item(WSP(const bf16_t, WS_Q), WSP(const bf16_t, WS_KV), WSP(const bf16_t, WS_KC), WSP(const bf16_t, WS_VCT), WSP(const float, WS_NG), WSP(bf16_t, WS_OATT), 2 * xcd + (k >> 1), (k & 1) ? ((k >> 1) ? 31 - j : j) : 63 - ((k >> 1) ? 31 - j : j), lds);
            } else {
#pragma unroll 1
                for (int i = bid; i < 16 * 64; i += G) attn_item(WSP(const bf16_t, WS_Q), WSP(const bf16_t, WS_KV), WSP(const bf16_t, WS_KC), WSP(const bf16_t, WS_VCT), WSP(const float, WS_NG), WSP(bf16_t, WS_OATT), i & 15, 63 - (i >> 4), lds);
            }
        } PHASE_END
        PHASE_BEGIN {
            pg8::Gemm gm{WSP(const bf16_t, WS_OATT), WSP(const bf16_t, WS_WAP) + (size_t)L * DM * DM, T, DM, DM, DM, DM}; pg8::StaticOrder S; S.init(T, DM, G, bid);
            EpiAP E{WSP(bf16_t, WS_MP), WSP(const bf16_t, WS_MG)};
            pg8::gemm_phase<EpiAP>(lds, gm, S, E);
        } PHASE_END_NOBAR
        PHASE_BEGIN {
            pg8::Gemm gm{WSP(const bf16_t, WS_VB), WSP(const bf16_t, WS_WCO) + (size_t)L * DM * DM, T, DM, DM, DM, DM}; pg8::StaticOrder S; S.init(T, DM, G, bid);
            EpiCO E{WSP(const bf16_t, WS_MP), WSP(const bf16_t, WS_MG), WSP(bf16_t, WS_MB)};
            pg8::gemm_phase<EpiCO>(lds, gm, S, E);
        } PHASE_END
        PHASE_BEGIN {
            pg8::Gemm gm{WSP(const bf16_t, WS_MB), WSP(const bf16_t, WS_WO) + (size_t)L * DM * DM, T, DM, DM, DM, DM}; pg8::StaticOrder S; S.init(T, DM, G, bid);
            EpiRes E{L == 0 ? kp->in[0] : (const float*)kp->out, kp->out, WSP(bf16_t, WS_XB), WSP(float, WS_SS) + (size_t)(2 * L + 1) * T};
            pg8::gemm_phase<EpiRes>(lds, gm, S, E);
        } PHASE_END
        PHASE_BEGIN {
            pg8::Gemm gm{WSP(const bf16_t, WS_XB), WSP(const bf16_t, WS_WUP) + (size_t)L * FF * DM, T, FF, DM, DM, DM}; pg8::StaticOrder S; S.init(T, FF, G, bid);
            EpiUp E{WSP(const float, WS_SS) + (size_t)(2 * L + 1) * T, WSP(bf16_t, WS_H)};
            pg8::gemm_phase<EpiUp>(lds, gm, S, E);
        } PHASE_END
        PHASE_BEGIN {
            pg8::Gemm gm{WSP(const bf16_t, WS_H), WSP(const bf16_t, WS_WDN) + (size_t)L * DM * FF, T, DM, FF, FF, FF}; pg8::StaticOrder S; S.init(T, DM, G, bid);
            EpiRes E{(const float*)kp->out, kp->out, L + 1 < DEPTH ? WSP(bf16_t, WS_XB) : (bf16_t*)nullptr, WSP(float, WS_SS) + (size_t)(2 * L + 2) * T};
            pg8::gemm_phase<EpiRes>(lds, gm, S, E);
        } PHASE_END
    }
    PHASE_BEGIN {
        const float* ssf = WSP(const float, WS_SS) + (size_t)(2 * DEPTH) * T; const float* fg = kp->in[16]; float* out = kp->out;
        for (int i = bid * 512 + tidp; i < T * (DM / 4); i += G * 512) {
            const int row = i >> 9, c4 = i & 511;
            const float rstd = rsqrtf(ssf[row] * (1.0f / DM) + EPS);
            const f32x4 gq = *(const f32x4*)(fg + 4 * c4);
            f32x4 v = *(f32x4*)(out + (size_t)i * 4);
            v = v * rstd * gq;
            *(f32x4*)(out + (size_t)i * 4) = v;
        }
    } PHASE_END
#undef PHASE_BEGIN
#undef PHASE_END
#undef WSP
}

#ifndef N_LAUNCH_MODE
#define N_LAUNCH_MODE 1
#endif
extern "C" void kernel_launch(void* const* d_in, const int* in_sizes, int n_in, void* d_out, int out_size, void* d_ws, size_t ws_size, hipStream_t stream) {
    static int grid = 0;
    if (grid == 0) {
        if (n_in != 17 || out_size != T * DM || ws_size < WS_END) { fprintf(stderr, "kernel_launch: unexpected problem (n_in %d out %d ws %zu, need %zu)\n", n_in, out_size, ws_size, (size_t)WS_END); grid = -1; return; }
        int dev = 0, cus = 0, per_cu = 0;
        hipGetDevice(&dev); hipDeviceGetAttribute(&cus, hipDeviceAttributeMultiprocessorCount, dev);
        if (hipFuncSetAttribute((const void*)nsa_fwd, hipFuncAttributeMaxDynamicSharedMemorySize, LDS_BYTES) != hipSuccess) { fprintf(stderr, "kernel_launch: hipFuncSetAttribute failed\n"); grid = -1; return; }
        if (hipOccupancyMaxActiveBlocksPerMultiprocessor(&per_cu, (const void*)nsa_fwd, 512, LDS_BYTES) != hipSuccess || per_cu < 1) { fprintf(stderr, "kernel_launch: occupancy query says %d\n", per_cu); per_cu = 1; }
        (void)hipGetLastError();
        grid = cus * (per_cu > 1 ? 1 : per_cu);
        if (grid <= 0) grid = 256;
    }
    if (grid < 0) return;
    Params p{};
    for (int i = 0; i < 17; ++i) p.in[i] = (const float*)d_in[i];
    p.out = (float*)d_out; p.ws = (unsigned char*)d_ws;
#if N_LAUNCH_MODE == 1
    p.lo = 0; p.hi = NPH; p.coop = 1;
    void* args[] = {&p};
    hipError_t e = hipLaunchCooperativeKernel((const void*)nsa_fwd, dim3(grid), dim3(512), args, LDS_BYTES, stream);
    if (e != hipSuccess) fprintf(stderr, "cooperative launch failed: %s (grid %d)\n", hipGetErrorString(e), grid);
#else
    for (int ph = 0; ph < NPH; ++ph) {
        p.lo = ph; p.hi = ph + 1; p.coop = 0;
        hipLaunchKernelGGL(nsa_fwd, dim3(grid), dim3(512), LDS_BYTES, stream, p);
    }
#endif
}
```

```cpp
#include <hip/hip_runtime.h>
#include <hip/hip_cooperative_groups.h>
#include <cstdio>
#include <cstdint>
namespace cg = cooperative_groups;

#define LAS __attribute__((address_space(3)))
typedef unsigned short bf16_t;
typedef short bf16x8 __attribute__((ext_vector_type(8)));
typedef short bf16x4 __attribute__((ext_vector_type(4)));
typedef float f32x4 __attribute__((ext_vector_type(4)));
typedef unsigned u32x4 __attribute__((ext_vector_type(4)));
typedef unsigned u32x2 __attribute__((ext_vector_type(2)));

constexpr int T = 16384, DM = 2048, SEQ = 4096, NBATCH = 4, DEPTH = 2;
constexpr int IN_COLS = 15408, NIN = 15616;
constexpr int FF = 8192;
constexpr float EPS = 1e-6f;
constexpr float QSCALE = 0.08838834764831845f * 1.4426950408889634f;

constexpr size_t MiB = 1u << 20;
constexpr size_t WS_Q = 0, WS_KV = 64 * MiB, WS_CV = 160 * MiB, WS_MG = 352 * MiB;
constexpr size_t WS_H = 0, WS_MP = 160 * MiB, WS_MB = 288 * MiB;
constexpr size_t WS_XB = 480 * MiB, WS_OATT = 480 * MiB, WS_VB = 544 * MiB;
constexpr size_t WS_WIN = 608 * MiB, WS_WAP = 730 * MiB, WS_WCO = 746 * MiB, WS_WO = 762 * MiB, WS_WUP = 778 * MiB, WS_WDN = 842 * MiB;
constexpr size_t WS_CW1 = 906 * MiB, WS_CW2 = 914 * MiB, WS_HID = 915 * MiB, WS_KC = 919 * MiB, WS_VCT = 920 * MiB, WS_NG = 921 * MiB;
constexpr size_t WS_ROPE = 924 * MiB, WS_SS = 926 * MiB, WS_CB = 927 * MiB, WS_C2T = 928 * MiB, WS_BAR = 932 * MiB, WS_END = 933 * MiB;
constexpr size_t KVJ = (size_t)16 * SEQ * 128;

struct Params {
    const float* in[17];
    float* out;
    unsigned char* ws;
    int lo, hi, coop, pad;
};

__device__ __forceinline__ unsigned cvt_pk_bf16(float lo, float hi) { unsigned r; asm volatile("v_cvt_pk_bf16_f32 %0, %1, %2" : "=v"(r) : "v"(lo), "v"(hi)); return r; }
__device__ __forceinline__ float bf2f(unsigned short v) { return __uint_as_float(((unsigned)v) << 16); }
__device__ __forceinline__ float bflo(unsigned w) { return __uint_as_float(w << 16); }
__device__ __forceinline__ float bfhi(unsigned w) { return __uint_as_float(w & 0xffff0000u); }
__device__ __forceinline__ float sigmoidf_(float x) { return __builtin_amdgcn_rcpf(1.0f + __builtin_amdgcn_exp2f(-1.4426950408889634f * x)); }
__device__ __forceinline__ int ropeperm(int p) { const int t = p >> 2, j = p & 3; return 2 * t + (j >> 1) + 64 * (j & 1); }

namespace pg8 {
constexpr int BM = 256, BK = 64, HALF = 128, HTB = HALF * BK * 2, STAGE_BYTES = 8 * HTB, NXCD = 8, WGM = 8;
__device__ __forceinline__ int lds_byte(int r, int c) { const int st = (r >> 4) * 2 + (c >> 5), rr = r & 15, cc = c & 31, ob = rr * 64 + cc * 2; return st * 1024 + (ob ^ (((ob >> 9) & 1) << 5)); }
__device__ __forceinline__ void stage_rc(int b, int& R, int& C) { const int st = b / 1024, sb = b % 1024, swz = sb ^ (((sb >> 9) & 1) << 5); R = (st >> 1) * 16 + swz / 64; C = (st & 1) * 32 + (swz % 64) / 2; }
__device__ __forceinline__ int perm32(int rho) { const int n = rho >> 4, i = rho & 15; return 8 * (i >> 2) + 4 * n + (i & 3); }
struct Unit { int pm, pn; };
struct Gemm { const bf16_t* A; const bf16_t* Bt; int M, N, K, lda, ldb; };
struct StaticOrder {
    int nM, nN, nwg, G, c;
    __device__ __forceinline__ void init(int M, int N, int G_, int c_) { nM = M / BM; nN = N / BM; nwg = nM * nN; G = G_; c = c_; }
    __device__ __forceinline__ bool next(int i, Unit& u) const {
        const long L = (long)i * G + c; if (L >= nwg) return false;
        int wgid = (int)L; { const int q = nwg / NXCD, r = nwg % NXCD, xcd = wgid % NXCD, off = wgid / NXCD; wgid = (xcd < r ? xcd * (q + 1) : r * (q + 1) + (xcd - r) * q) + off; }
        const int nig = WGM * nN, gid = wgid / nig, fm = gid * WGM, gsz = (nM - fm) < WGM ? (nM - fm) : WGM;
        u.pm = fm + ((wgid % nig) % gsz); u.pn = (wgid % nig) / gsz; return true;
    }
};
template <class Epi>
__device__ __forceinline__ void gemm_phase(LAS unsigned char* lds, const Gemm g, const StaticOrder& S, const Epi& E) {
    int tid = threadIdx.x; asm volatile("" : "+v"(tid));
    const int wid = __builtin_amdgcn_readfirstlane(tid >> 6), lane = tid & 63, wr = wid >> 2, wc = wid & 3, fr = lane & 15, fq = lane >> 4;
    const int K = g.K, nt = K / BK;
    unsigned voffA[2], voffB[2];
#pragma unroll
    for (int i = 0; i < 2; ++i) { int R, C; stage_rc(tid * 16 + i * 8192, R, C); const int Rb = Epi::PERM ? ((R & ~31) + perm32(R & 31)) : R;
        voffA[i] = (unsigned)(R * g.lda + C) * 2u; voffB[i] = (unsigned)(Rb * g.ldb + C) * 2u; }
    const size_t kstep = (size_t)(BK * 2);
    const size_t hstepA = (size_t)HALF * g.lda * 2, hstepB = (size_t)HALF * g.ldb * 2;
    const size_t tstepA = 2 * hstepA, tstepB = 2 * hstepB;
    const unsigned ldsw = (unsigned)wid * 1024u;
    const int aoff = lds_byte(wr * 64 + fr, fq * 8), boff = lds_byte(wc * 32 + fr, fq * 8);
#define PG8_SA(b, h) (((b) * 2 + (h)) * HTB)
#define PG8_SB(b, h) ((4 + (b) * 2 + (h)) * HTB)
#define PG8_STAGE(bufoff, gbase, voff) do { _Pragma("unroll") for (int _i = 0; _i < 2; ++_i) \
        __builtin_amdgcn_global_load_lds((const unsigned*)((const char*)(gbase) + (voff)[_i]), (LAS unsigned*)(lds + (bufoff) + ldsw + _i * 8192), 16, 0, 0); } while (0)
#define PG8_LDA(dst, b, h) do { _Pragma("unroll") for (int m = 0; m < 4; ++m) _Pragma("unroll") for (int k = 0; k < 2; ++k) dst[m][k] = *(const LAS bf16x8*)(lds + PG8_SA(b, h) + aoff + m * 2048 + k * 1024); } while (0)
#define PG8_LDB(dst, b, h) do { _Pragma("unroll") for (int n = 0; n < 2; ++n) _Pragma("unroll") for (int k = 0; k < 2; ++k) dst[n][k] = *(const LAS bf16x8*)(lds + PG8_SB(b, h) + boff + n * 2048 + k * 1024); } while (0)
#define PG8_MMA(ai, bj, At, Bt) do { __builtin_amdgcn_s_setprio(1); _Pragma("unroll") for (int m = 0; m < 4; ++m) _Pragma("unroll") for (int n = 0; n < 2; ++n) _Pragma("unroll") for (int k = 0; k < 2; ++k) \
        acc[ai][bj][m][n] = __builtin_amdgcn_mfma_f32_16x16x32_bf16(Bt[n][k], At[m][k], acc[ai][bj][m][n], 0, 0, 0); __builtin_amdgcn_s_setprio(0); } while (0)
#define PG8_WAIT_V(n) asm volatile("s_waitcnt vmcnt(" #n ")" ::: "memory")
#define PG8_WAIT_L(n) asm volatile("s_waitcnt lgkmcnt(" #n ")" ::: "memory")
#define PG8_BAR __builtin_amdgcn_s_barrier()
#define PG8_SCHED __builtin_amdgcn_sched_barrier(0)
    Unit cur, nxt; int ui = 0;
    if (!S.next(0, cur)) return;
    f32x4 acc[2][2][4][2];
#pragma unroll
    for (int a = 0; a < 2; ++a)
#pragma unroll
        for (int b = 0; b < 2; ++b)
#pragma unroll
            for (int m = 0; m < 4; ++m)
#pragma unroll
                for (int n = 0; n < 2; ++n) acc[a][b][m][n] = (f32x4){0.f, 0.f, 0.f, 0.f};
    bf16x8 At[4][2], B0[2][2], B1[2][2];
    const char* cA = (const char*)g.A + (size_t)cur.pm * tstepA; const char* cB = (const char*)g.Bt + (size_t)cur.pn * tstepB;
    PG8_STAGE(PG8_SB(0, 0), cB, voffB); PG8_STAGE(PG8_SB(0, 1), cB + hstepB, voffB); PG8_STAGE(PG8_SA(0, 0), cA, voffA); PG8_STAGE(PG8_SA(0, 1), cA + hstepA, voffA);
    if (wr == 1) PG8_BAR;
    PG8_WAIT_V(2); PG8_BAR;
    PG8_STAGE(PG8_SB(1, 0), cB + kstep, voffB); PG8_STAGE(PG8_SA(1, 0), cA + kstep, voffA); PG8_STAGE(PG8_SB(1, 1), cB + hstepB + kstep, voffB);
    PG8_WAIT_V(6); PG8_BAR;
    for (;;) {
        const bool has_next = S.next(ui + 1, nxt);
        const char* nA = has_next ? (const char*)g.A + (size_t)nxt.pm * tstepA : cA; const char* nB = has_next ? (const char*)g.Bt + (size_t)nxt.pn * tstepB : cB;
        for (int t = 0; t < nt; t += 2) {
            const bool last = (t == nt - 2);
            const char* a1 = cA + (size_t)(t + 1) * kstep;
            const char* a2 = last ? nA : cA + (size_t)(t + 2) * kstep; const char* b2 = last ? nB : cB + (size_t)(t + 2) * kstep;
            const char* a3 = a2 + kstep; const char* b3 = b2 + kstep;
            PG8_LDB(B0, 0, 0); PG8_LDB(B1, 0, 1); PG8_SCHED; PG8_LDA(At, 0, 0); PG8_STAGE(PG8_SA(1, 1), a1 + hstepA, voffA);
            PG8_WAIT_V(8); PG8_WAIT_L(0); PG8_BAR; PG8_MMA(0, 0, At, B0); PG8_MMA(0, 1, At, B1); PG8_BAR; PG8_SCHED;
            PG8_LDA(At, 0, 1); PG8_STAGE(PG8_SB(0, 0), b2, voffB); PG8_STAGE(PG8_SB(0, 1), b2 + hstepB, voffB); PG8_STAGE(PG8_SA(0, 0), a2, voffA);
            PG8_WAIT_V(8); PG8_WAIT_L(0); PG8_BAR; PG8_MMA(1, 0, At, B0); PG8_MMA(1, 1, At, B1); PG8_BAR; PG8_SCHED;
            PG8_LDB(B0, 1, 0); PG8_LDB(B1, 1, 1); PG8_SCHED; PG8_LDA(At, 1, 0); PG8_STAGE(PG8_SA(0, 1), a2 + hstepA, voffA);
            PG8_WAIT_V(8); PG8_WAIT_L(0); PG8_BAR; PG8_MMA(0, 0, At, B0); PG8_MMA(0, 1, At, B1); PG8_BAR; PG8_SCHED;
            PG8_LDA(At, 1, 1); PG8_STAGE(PG8_SB(1, 0), b3, voffB); PG8_STAGE(PG8_SB(1, 1), b3 + hstepB, voffB); PG8_STAGE(PG8_SA(1, 0), a3, voffA);
            PG8_WAIT_V(8); PG8_WAIT_L(0); PG8_BAR; PG8_MMA(1, 0, At, B0); PG8_MMA(1, 1, At, B1); PG8_BAR; PG8_SCHED;
        }
        if (wr == 0) PG8_BAR;
        E(acc, cur, wr, wc, fr, fq);
        if (!has_next) break;
#pragma unroll
        for (int a = 0; a < 2; ++a)
#pragma unroll
            for (int b = 0; b < 2; ++b)
#pragma unroll
                for (int m = 0; m < 4; ++m)
#pragma unroll
                    for (int n = 0; n < 2; ++n) acc[a][b][m][n] = (f32x4){0.f, 0.f, 0.f, 0.f};
        cur = nxt; cA = nA; cB = nB; ++ui;
        if (wr == 1) PG8_BAR;
    }
    PG8_WAIT_V(0);
    PG8_BAR;
#undef PG8_SA
#undef PG8_SB
#undef PG8_STAGE
#undef PG8_LDA
#undef PG8_LDB
#undef PG8_MMA
#undef PG8_WAIT_V
#undef PG8_WAIT_L
#undef PG8_BAR
#undef PG8_SCHED
}
}
using pg8::Unit;

__device__ __forceinline__ float qmax(float v) {
    { unsigned a = __float_as_uint(v), b = a; auto r = __builtin_amdgcn_permlane32_swap(a, b, false, false); const unsigned x = r[0], y = r[1]; v = fmaxf(__uint_as_float(x), __uint_as_float(y)); }
    { unsigned a = __float_as_uint(v), b = a; auto r = __builtin_amdgcn_permlane16_swap(a, b, false, false); const unsigned x = r[0], y = r[1]; v = fmaxf(__uint_as_float(x), __uint_as_float(y)); }
    return v;
}
__device__ __forceinline__ float qsum(float v) {
    { unsigned a = __float_as_uint(v), b = a; auto r = __builtin_amdgcn_permlane32_swap(a, b, false, false); const unsigned x = r[0], y = r[1]; v = __uint_as_float(x) + __uint_as_float(y); }
    { unsigned a = __float_as_uint(v), b = a; auto r = __builtin_amdgcn_permlane16_swap(a, b, false, false); const unsigned x = r[0], y = r[1]; v = __uint_as_float(x) + __uint_as_float(y); }
    return v;
}

__device__ __forceinline__ u32x4 pack8(const f32x4 a, const f32x4 b) { u32x4 w; w.x = cvt_pk_bf16(a[0], a[1]); w.y = cvt_pk_bf16(a[2], a[3]); w.z = cvt_pk_bf16(b[0], b[1]); w.w = cvt_pk_bf16(b[2], b[3]); return w; }
__device__ __forceinline__ void rope8(f32x4& v0, f32x4& v1, const f32x4 c4, const f32x4 s4) {
    const f32x4 a = v0, b = v1;
    v0[0] = a[0] * c4[0] - a[1] * s4[0]; v0[1] = a[1] * c4[0] + a[0] * s4[0];
    v0[2] = a[2] * c4[1] - a[3] * s4[1]; v0[3] = a[3] * c4[1] + a[2] * s4[1];
    v1[0] = b[0] * c4[2] - b[1] * s4[2]; v1[1] = b[1] * c4[2] + b[0] * s4[2];
    v1[2] = b[2] * c4[3] - b[3] * s4[3]; v1[3] = b[3] * c4[3] + b[2] * s4[3];
}

struct EpiIn {
    static constexpr bool PERM = true;
    const float* ss; const float* ropec; const float* ropes;
    bf16_t* Q; bf16_t* KV; bf16_t* CV; bf16_t* MG; float* NG;
    enum { M_PLAIN = 0, M_ROPE = 1, M_TRANS = 2, M_SIGM = 3, M_NG = 4 };
    __device__ __forceinline__ void operator()(const f32x4 (&acc)[2][2][4][2], const Unit& u, int wr, int wc, int fr, int fq) const {
        const int pn = u.pn; int mode; bf16_t* base0; bf16_t* base1; size_t bstride; int ld; float scale = 1.f;
        if (pn < 8) { mode = M_ROPE; base0 = Q + (2 * pn) * 128; base1 = base0 + 128; ld = DM; bstride = (size_t)SEQ * DM; scale = QSCALE; }
        else if (pn < 20) { const int hd = (pn - 8) * 2, j = hd >> 2, g = hd & 3; base0 = KV + (size_t)j * KVJ + (size_t)g * SEQ * 128; base1 = base0 + (size_t)SEQ * 128; ld = 128; bstride = (size_t)4 * SEQ * 128;
            mode = (j == 2 || j == 4) ? M_ROPE : ((j == 3 || j == 5) ? M_TRANS : M_PLAIN); }
        else if (pn < 44) { mode = M_PLAIN; base0 = CV + (pn - 20) * 256; base1 = base0 + 128; ld = 3 * DM; bstride = (size_t)SEQ * 3 * DM; }
        else if (pn < 60) { mode = M_SIGM; base0 = MG + (pn - 44) * 256; base1 = base0 + 128; ld = 2 * DM; bstride = (size_t)SEQ * 2 * DM; }
        else { mode = M_NG; base0 = nullptr; base1 = nullptr; ld = 0; bstride = 0; }
        const int p0 = wc * 32 + 8 * fq;
        float rs[8];
#pragma unroll
        for (int i = 0; i < 8; ++i) rs[i] = ss[u.pm * 256 + (i >> 2) * 128 + wr * 64 + (i & 3) * 16 + fr];
#pragma unroll
        for (int i = 0; i < 8; ++i) rs[i] = rsqrtf(rs[i] * (1.0f / DM) + EPS);
#pragma unroll
        for (int ai = 0; ai < 2; ++ai)
#pragma unroll
            for (int m = 0; m < 4; ++m) {
                const int r = u.pm * 256 + ai * 128 + wr * 64 + m * 16 + fr;
                const float rstd = rs[ai * 4 + m];
                const int pos = r & (SEQ - 1), b = r >> 12;
                f32x4 v0 = acc[ai][0][m][0] * rstd, v1 = acc[ai][0][m][1] * rstd, w0 = acc[ai][1][m][0] * rstd, w1 = acc[ai][1][m][1] * rstd;
                const size_t off = (size_t)b * bstride + (size_t)pos * ld + p0;
                if (mode == M_ROPE) {
                    const f32x4 c4 = *(const f32x4*)(ropec + pos * 64 + wc * 16 + 4 * fq), s4 = *(const f32x4*)(ropes + pos * 64 + wc * 16 + 4 * fq);
                    rope8(v0, v1, c4, s4); rope8(w0, w1, c4, s4);
                    *(u32x4*)(base0 + off) = pack8(v0 * scale, v1 * scale); *(u32x4*)(base1 + off) = pack8(w0 * scale, w1 * scale);
                } else if (mode == M_PLAIN) {
                    *(u32x4*)(base0 + off) = pack8(v0, v1); *(u32x4*)(base1 + off) = pack8(w0, w1);
                } else if (mode == M_SIGM) {
#pragma unroll
                    for (int e = 0; e < 4; ++e) { v0[e] = sigmoidf_(v0[e]); v1[e] = sigmoidf_(v1[e]); w0[e] = sigmoidf_(w0[e]); w1[e] = sigmoidf_(w1[e]); }
                    *(u32x4*)(base0 + off) = pack8(v0, v1); *(u32x4*)(base1 + off) = pack8(w0, w1);
                } else if (mode == M_TRANS) {
                    const size_t toff = (size_t)b * bstride + (size_t)p0 * SEQ + pos;
                    { bf16_t* d = base0 + toff; const u32x4 w = pack8(v0, v1);
                      d[0 * SEQ] = (bf16_t)(w.x & 0xffff); d[1 * SEQ] = (bf16_t)(w.x >> 16); d[2 * SEQ] = (bf16_t)(w.y & 0xffff); d[3 * SEQ] = (bf16_t)(w.y >> 16);
                      d[4 * SEQ] = (bf16_t)(w.z & 0xffff); d[5 * SEQ] = (bf16_t)(w.z >> 16); d[6 * SEQ] = (bf16_t)(w.w & 0xffff); d[7 * SEQ] = (bf16_t)(w.w >> 16); }
                    { bf16_t* d = base1 + toff; const u32x4 w = pack8(w0, w1);
                      d[0 * SEQ] = (bf16_t)(w.x & 0xffff); d[1 * SEQ] = (bf16_t)(w.x >> 16); d[2 * SEQ] = (bf16_t)(w.y & 0xffff); d[3 * SEQ] = (bf16_t)(w.y >> 16);
                      d[4 * SEQ] = (bf16_t)(w.z & 0xffff); d[5 * SEQ] = (bf16_t)(w.z >> 16); d[6 * SEQ] = (bf16_t)(w.w & 0xffff); d[7 * SEQ] = (bf16_t)(w.w >> 16); }
                } else {
#pragma unroll
                    for (int e = 0; e < 4; ++e) { if (p0 + e < 48) NG[(size_t)r * 48 + p0 + e] = sigmoidf_(v0[e]); if (p0 + 4 + e < 48) NG[(size_t)r * 48 + p0 + 4 + e] = sigmoidf_(v1[e]); }
                }
            }
    }
};

struct EpiC1S {
    static constexpr bool PERM = false;
    float* HIDP; int row0, coff;
    __device__ __forceinline__ void operator()(const f32x4 (&acc)[2][2][4][2], const Unit& u, int wr, int wc, int fr, int fq) const {
#pragma unroll
        for (int ai = 0; ai < 2; ++ai)
#pragma unroll
            for (int m = 0; m < 4; ++m) {
                float* rp = HIDP + (size_t)(row0 + ai * 128 + wr * 64 + m * 16 + fr) * 512 + coff + wc * 32 + 4 * fq;
#pragma unroll
                for (int bj = 0; bj < 2; ++bj)
#pragma unroll
                    for (int n = 0; n < 2; ++n) *(f32x4*)(rp + bj * 128 + n * 16) = acc[ai][bj][m][n];
            }
    }
};
struct EpiC2 {
    static constexpr bool PERM = false;
    float* C2T;
    __device__ __forceinline__ void operator()(const f32x4 (&acc)[2][2][4][2], const Unit& u, int wr, int wc, int fr, int fq) const {
#pragma unroll
        for (int ai = 0; ai < 2; ++ai)
#pragma unroll
            for (int m = 0; m < 4; ++m) {
                const int r = u.pm * 256 + ai * 128 + wr * 64 + m * 16 + fr;
#pragma unroll
                for (int bj = 0; bj < 2; ++bj)
#pragma unroll
                    for (int n = 0; n < 2; ++n) *(f32x4*)(C2T + (size_t)r * 256 + bj * 128 + wc * 32 + n * 16 + 4 * fq) = acc[ai][bj][m][n];
            }
    }
};
__device__ __forceinline__ void c2_finish_bg(const float* C2T, const float* ropec, const float* ropes, bf16_t* KC, bf16_t* VCT, int bg, int tid) {
    for (int i = tid; i < 256 * 64; i += 512) {
        const int n = i >> 6, f = i & 63, row = bg * 256 + n;
        float o1 = 0.f, o2 = 0.f;
        if (n != 255) { const int pos = 16 * n + 31; const float x1 = C2T[(size_t)row * 256 + 2 * f], x2 = C2T[(size_t)row * 256 + 2 * f + 1], c = ropec[pos * 64 + f], s = ropes[pos * 64 + f]; o1 = x1 * c - x2 * s; o2 = x2 * c + x1 * s; }
        *(unsigned*)(KC + (size_t)row * 128 + 2 * f) = cvt_pk_bf16(o1, o2);
    }
    for (int i = tid; i < 128 * 256; i += 512) {
        const int n = i & 255, d = i >> 8;
        const float v = (n != 255) ? C2T[((size_t)bg * 256 + n) * 256 + 128 + d] : 0.f;
        VCT[((size_t)bg * 128 + d) * 256 + n] = (bf16_t)(cvt_pk_bf16(v, 0.f) & 0xffff);
    }
}
__device__ __forceinline__ void c2_finish(const float* C2T, const float* ropec, const float* ropes, bf16_t* KC, bf16_t* VCT, int gt, int NGT) {
    for (int i = gt; i < 4096 * 64; i += NGT) {
        const int row = i >> 6, f = i & 63, n = row & 255;
        float o1 = 0.f, o2 = 0.f;
        if (n != 255) { const int pos = 16 * n + 31; const float x1 = C2T[(size_t)row * 256 + 2 * f], x2 = C2T[(size_t)row * 256 + 2 * f + 1], c = ropec[pos * 64 + f], s = ropes[pos * 64 + f]; o1 = x1 * c - x2 * s; o2 = x2 * c + x1 * s; }
        *(unsigned*)(KC + (size_t)row * 128 + 2 * f) = cvt_pk_bf16(o1, o2);
    }
    for (int i = gt; i < 16 * 128 * 256; i += NGT) {
        const int n = i & 255, d = (i >> 8) & 127, bg = i >> 15;
        const float v = (n != 255) ? C2T[((size_t)bg * 256 + n) * 256 + 128 + d] : 0.f;
        VCT[i] = (bf16_t)(cvt_pk_bf16(v, 0.f) & 0xffff);
    }
}
struct EpiAP {
    static constexpr bool PERM = true;
    bf16_t* MP; const bf16_t* MG;
    __device__ __forceinline__ void operator()(const f32x4 (&acc)[2][2][4][2], const Unit& u, int wr, int wc, int fr, int fq) const {
#pragma unroll
        for (int ai = 0; ai < 2; ++ai) {
            u32x4 gw[4][2];
#pragma unroll
            for (int m = 0; m < 4; ++m)
#pragma unroll
                for (int bj = 0; bj < 2; ++bj)
                    gw[m][bj] = *(const u32x4*)(MG + (size_t)(u.pm * 256 + ai * 128 + wr * 64 + m * 16 + fr) * 4096 + u.pn * 256 + bj * 128 + wc * 32 + 8 * fq);
#pragma unroll
            for (int m = 0; m < 4; ++m) {
                const int r = u.pm * 256 + ai * 128 + wr * 64 + m * 16 + fr;
#pragma unroll
                for (int bj = 0; bj < 2; ++bj) {
                    const int c = u.pn * 256 + bj * 128 + wc * 32 + 8 * fq;
                    const u32x4 g4 = gw[m][bj];
                    f32x4 v0 = acc[ai][bj][m][0], v1 = acc[ai][bj][m][1];
                    v0[0] *= bflo(g4.x); v0[1] *= bfhi(g4.x); v0[2] *= bflo(g4.y); v0[3] *= bfhi(g4.y);
                    v1[0] *= bflo(g4.z); v1[1] *= bfhi(g4.z); v1[2] *= bflo(g4.w); v1[3] *= bfhi(g4.w);
                    *(u32x4*)(MP + (size_t)r * DM + c) = pack8(v0, v1);
                }
            }
        }
    }
};
struct EpiCO {
    static constexpr bool PERM = true;
    const bf16_t* MP; const bf16_t* MG; bf16_t* MB;
    __device__ __forceinline__ void operator()(const f32x4 (&acc)[2][2][4][2], const Unit& u, int wr, int wc, int fr, int fq) const {
#pragma unroll
        for (int ai = 0; ai < 2; ++ai) {
            u32x4 gw[4][2], mp[4][2];
#pragma unroll
            for (int m = 0; m < 4; ++m)
#pragma unroll
                for (int bj = 0; bj < 2; ++bj) {
                    const size_t r = (size_t)(u.pm * 256 + ai * 128 + wr * 64 + m * 16 + fr); const int c = u.pn * 256 + bj * 128 + wc * 32 + 8 * fq;
                    gw[m][bj] = *(const u32x4*)(MG + r * 4096 + 2048 + c); mp[m][bj] = *(const u32x4*)(MP + r * DM + c);
                }
#pragma unroll
            for (int m = 0; m < 4; ++m)
#pragma unroll
                for (int bj = 0; bj < 2; ++bj) {
                    const size_t r = (size_t)(u.pm * 256 + ai * 128 + wr * 64 + m * 16 + fr); const int c = u.pn * 256 + bj * 128 + wc * 32 + 8 * fq;
                    const u32x4 g4 = gw[m][bj], p4 = mp[m][bj];
                    f32x4 v0 = acc[ai][bj][m][0], v1 = acc[ai][bj][m][1];
                    v0[0] = bflo(p4.x) + v0[0] * bflo(g4.x); v0[1] = bfhi(p4.x) + v0[1] * bfhi(g4.x); v0[2] = bflo(p4.y) + v0[2] * bflo(g4.y); v0[3] = bfhi(p4.y) + v0[3] * bfhi(g4.y);
                    v1[0] = bflo(p4.z) + v1[0] * bflo(g4.z); v1[1] = bfhi(p4.z) + v1[1] * bfhi(g4.z); v1[2] = bflo(p4.w) + v1[2] * bflo(g4.w); v1[3] = bfhi(p4.w) + v1[3] * bfhi(g4.w);
                    *(u32x4*)(MB + r * DM + c) = pack8(v0, v1);
                }
        }
    }
};
struct EpiRes {
    static constexpr bool PERM = true;
    const float* base; float* X; bf16_t* XB; float* ss;
    __device__ __forceinline__ void operator()(const f32x4 (&acc)[2][2][4][2], const Unit& u, int wr, int wc, int fr, int fq) const {
#pragma unroll
        for (int ai = 0; ai < 2; ++ai) {
            f32x4 bs[4][2][2];
#pragma unroll
            for (int m = 0; m < 4; ++m)
#pragma unroll
                for (int bj = 0; bj < 2; ++bj)
#pragma unroll
                    for (int n = 0; n < 2; ++n)
                        bs[m][bj][n] = *(const f32x4*)(base + (size_t)(u.pm * 256 + ai * 128 + wr * 64 + m * 16 + fr) * DM + u.pn * 256 + bj * 128 + wc * 32 + 8 * fq + 4 * n);
#pragma unroll
            for (int m = 0; m < 4; ++m) {
                const int r = u.pm * 256 + ai * 128 + wr * 64 + m * 16 + fr;
                float sq = 0.f;
#pragma unroll
                for (int bj = 0; bj < 2; ++bj) {
                    const int c = u.pn * 256 + bj * 128 + wc * 32 + 8 * fq;
                    const f32x4 v0 = acc[ai][bj][m][0] + bs[m][bj][0], v1 = acc[ai][bj][m][1] + bs[m][bj][1];
                    *(f32x4*)(X + (size_t)r * DM + c) = v0; *(f32x4*)(X + (size_t)r * DM + c + 4) = v1;
                    if (XB) *(u32x4*)(XB + (size_t)r * DM + c) = pack8(v0, v1);
                    sq += ((v0[0] * v0[0] + v0[1] * v0[1]) + (v0[2] * v0[2] + v0[3] * v0[3])) + ((v1[0] * v1[0] + v1[1] * v1[1]) + (v1[2] * v1[2] + v1[3] * v1[3]));
                }
                sq = qsum(sq);
                if (fq == 0) atomicAdd(ss + r, sq);
            }
        }
    }
};
struct EpiUp {
    static constexpr bool PERM = true;
    const float* ss; bf16_t* H;
    __device__ __forceinline__ void operator()(const f32x4 (&acc)[2][2][4][2], const Unit& u, int wr, int wc, int fr, int fq) const {
        float rs[8];
#pragma unroll
        for (int i = 0; i < 8; ++i) rs[i] = ss[u.pm * 256 + (i >> 2) * 128 + wr * 64 + (i & 3) * 16 + fr];
#pragma unroll
        for (int i = 0; i < 8; ++i) rs[i] = rsqrtf(rs[i] * (1.0f / DM) + EPS);
#pragma unroll
        for (int ai = 0; ai < 2; ++ai)
#pragma unroll
            for (int m = 0; m < 4; ++m) {
                const int r = u.pm * 256 + ai * 128 + wr * 64 + m * 16 + fr;
                const float rstd = rs[ai * 4 + m];
#pragma unroll
                for (int bj = 0; bj < 2; ++bj) {
                    f32x4 v0 = acc[ai][bj][m][0] * rstd, v1 = acc[ai][bj][m][1] * rstd;
#pragma unroll
                    for (int e = 0; e < 4; ++e) { const float a = fmaxf(v0[e], 0.f), b = fmaxf(v1[e], 0.f); v0[e] = a * a; v1[e] = b * b; }
                    *(u32x4*)(H + (size_t)r * FF + u.pn * 256 + bj * 128 + wc * 32 + 8 * fq) = pack8(v0, v1);
                }
            }
    }
};

constexpr int KB_BYTES = 17408, VB_BYTES = 18432, BUF_BYTES = KB_BYTES + VB_BYTES, KT_PITCH = 272, VT_PITCH = 144;
constexpr int IMP_OFF = 2 * BUF_BYTES, SELM_OFF = IMP_OFF + 65536;
constexpr float NEG_BIG = -1.0e30f;

struct StageRegs { u32x4 k[2], v[2]; };
template <bool DOK, bool DOV>
__device__ __forceinline__ void stage_load(StageRegs& R, const bf16_t* Kg, const bf16_t* VTg, int vpitch, int key0, int tid) {
#pragma unroll
    for (int i = 0; i < 2; ++i) {
        const int idx = tid + i * 512;
        if (DOK) R.k[i] = *(const u32x4*)(Kg + (size_t)(key0 + (idx >> 4)) * 128 + (idx & 15) * 8);
        if (DOV) R.v[i] = *(const u32x4*)(VTg + (size_t)(idx >> 3) * vpitch + key0 + (idx & 7) * 8);
    }
}
template <bool DOK, bool DOV>
__device__ __forceinline__ void stage_store(const StageRegs& R, LAS unsigned char* buf, int tid) {
#pragma unroll
    for (int i = 0; i < 2; ++i) {
        const int idx = tid + i * 512;
        if (DOK) *(LAS u32x4*)(buf + (idx >> 4) * KT_PITCH + (idx & 15) * 16) = R.k[i];
        if (DOV) *(LAS u32x4*)(buf + KB_BYTES + (idx >> 3) * VT_PITCH + (idx & 7) * 16) = R.v[i];
    }
}
__device__ __forceinline__ void qk_tile2(f32x4 (&s)[2][4], const bf16x8 (&qf)[2][4], const LAS unsigned char* buf, int ql, int g, float init0 = 0.f, float init1 = 0.f) {
#pragma unroll
    for (int sub = 0; sub < 4; ++sub) { s[0][sub] = (f32x4){init0, init0, init0, init0}; s[1][sub] = (f32x4){init1, init1, init1, init1}; }
#pragma unroll
    for (int kc = 0; kc < 4; ++kc) {
        bf16x8 kf[4];
#pragma unroll
        for (int sub = 0; sub < 4; ++sub) kf[sub] = *(const LAS bf16x8*)(buf + (16 * sub + ql) * KT_PITCH + kc * 64 + g * 16);
#pragma unroll
        for (int sub = 0; sub < 4; ++sub) {
            s[0][sub] = __builtin_amdgcn_mfma_f32_16x16x32_bf16(kf[sub], qf[0][kc], s[0][sub], 0, 0, 0);
            s[1][sub] = __builtin_amdgcn_mfma_f32_16x16x32_bf16(kf[sub], qf[1][kc], s[1][sub], 0, 0, 0);
        }
        if (kc & 1) asm volatile("" ::: "memory");
    }
}
__device__ __forceinline__ void pv_tile2(f32x4 (&o)[2][8], const u32x4 (&pk)[2][2], const LAS unsigned char* buf, int ql, int g) {
#pragma unroll
    for (int ch = 0; ch < 2; ++ch) {
        const bf16x8 pf0 = __builtin_bit_cast(bf16x8, pk[0][ch]), pf1 = __builtin_bit_cast(bf16x8, pk[1][ch]);
#pragma unroll
        for (int dt = 0; dt < 8; ++dt) {
            const LAS unsigned char* rowp = buf + KB_BYTES + (16 * dt + ql) * VT_PITCH + (32 * ch + 4 * g) * 2;
            const u32x2 lo = *(const LAS u32x2*)(rowp), hi = *(const LAS u32x2*)(rowp + 32);
            const bf16x8 vf = __builtin_bit_cast(bf16x8, (u32x4){lo.x, lo.y, hi.x, hi.y});
            o[0][dt] = __builtin_amdgcn_mfma_f32_16x16x32_bf16(vf, pf0, o[0][dt], 0, 0, 0);
            o[1][dt] = __builtin_amdgcn_mfma_f32_16x16x32_bf16(vf, pf1, o[1][dt], 0, 0, 0);
            if ((dt & 3) == 3) asm volatile("" ::: "memory");
        }
    }
}
template <bool FULL>
__device__ __forceinline__ void softmax_tile(f32x4 (&s)[4], f32x4 (&o)[8], u32x4 (&pk)[2], float& mrun, float& lsum, bool take, int rel, int lowrel) {
    float mx = NEG_BIG;
    if (FULL) {
#pragma unroll
        for (int sub = 0; sub < 4; ++sub) { float m2; asm("v_max3_f32 %0, %1, %2, %3" : "=v"(m2) : "v"(mx), "v"(s[sub][0]), "v"(s[sub][1])); asm("v_max3_f32 %0, %1, %2, %3" : "=v"(mx) : "v"(m2), "v"(s[sub][2]), "v"(s[sub][3])); }
        mx = take ? mx : NEG_BIG;
    } else {
#pragma unroll
        for (int sub = 0; sub < 4; ++sub)
#pragma unroll
            for (int e = 0; e < 4; ++e) { const int kk = sub * 16 + e; const bool ok = take && kk <= rel && kk > lowrel; s[sub][e] = ok ? s[sub][e] : NEG_BIG; mx = fmaxf(mx, s[sub][e]); }
    }
    mx = qmax(mx);
    const float mnew = fmaxf(mrun, mx), alpha = __builtin_amdgcn_exp2f(mrun - mnew);
    mrun = mnew;
    float ps = 0.f;
    if (FULL) {
        const float c = take ? -mnew : -__builtin_inff();
#pragma unroll
        for (int sub = 0; sub < 4; ++sub)
#pragma unroll
            for (int e = 0; e < 4; ++e) { const float pv = __builtin_amdgcn_exp2f(s[sub][e] + c); s[sub][e] = pv; ps += pv; }
    } else {
#pragma unroll
        for (int sub = 0; sub < 4; ++sub)
#pragma unroll
            for (int e = 0; e < 4; ++e) { const float pv = (s[sub][e] > -1.0e29f) ? __builtin_amdgcn_exp2f(s[sub][e] - mnew) : 0.f; s[sub][e] = pv; ps += pv; }
    }
    lsum = lsum * alpha + ps;
#pragma unroll
    for (int dt = 0; dt < 8; ++dt) o[dt] = o[dt] * alpha;
    pk[0] = pack8(s[0], s[1]); pk[1] = pack8(s[2], s[3]);
}

__device__ __forceinline__ float local_max16(const f32x4 (&sp)[4]) {
    float mx = sp[0][0];
#pragma unroll
    for (int sub = 0; sub < 4; ++sub) { float m2; asm("v_max3_f32 %0, %1, %2, %3" : "=v"(m2) : "v"(mx), "v"(sp[sub][0]), "v"(sp[sub][1])); asm("v_max3_f32 %0, %1, %2, %3" : "=v"(mx) : "v"(m2), "v"(sp[sub][2]), "v"(sp[sub][3])); }
    return mx;
}
constexpr float DEFER_THRESH = 10.0f;

template <int MODE, bool DEFER>
__device__ __forceinline__ void flash_step(int tile, int tile_hi, f32x4 (&o)[2][8], float (&lsum)[2], float (&mrun)[2], StageRegs& R, const bf16x8 (&qf)[2][4], const bf16_t* Kg, const bf16_t* VTg, int vpitch,
                                           const int (&t)[2], const unsigned long long (&selm)[2], LAS unsigned char* lds, int tid, int ql, int g) {
    const LAS unsigned char* buf = lds + (tile & 1) * BUF_BYTES;
    bool take[2] = {true, true};
    if (MODE == 1) { take[0] = ((selm[0] >> tile) & 1ull) != 0ull; take[1] = ((selm[1] >> tile) & 1ull) != 0ull; }
    f32x4 s[2][4];
    if (DEFER) qk_tile2(s, qf, buf, ql, g, take[0] ? -mrun[0] : -__builtin_inff(), take[1] ? -mrun[1] : -__builtin_inff());
    else qk_tile2(s, qf, buf, ql, g);
    if (tile < tile_hi) stage_load<true, true>(R, Kg, VTg, vpitch, (tile + 1) * 64, tid);
    u32x4 pk[2][2];
    if (DEFER) {
        float m0 = local_max16(s[0]), m1 = local_max16(s[1]);
        if (__any(m0 > DEFER_THRESH || m1 > DEFER_THRESH)) {
            m0 = fmaxf(qmax(m0), 0.f); m1 = fmaxf(qmax(m1), 0.f);
            const float a0 = __builtin_amdgcn_exp2f(-m0), a1 = __builtin_amdgcn_exp2f(-m1);
            mrun[0] += m0; mrun[1] += m1; lsum[0] *= a0; lsum[1] *= a1;
#pragma unroll
            for (int dt = 0; dt < 8; ++dt) { o[0][dt] = o[0][dt] * a0; o[1][dt] = o[1][dt] * a1; }
#pragma unroll
            for (int sub = 0; sub < 4; ++sub) { s[0][sub] = s[0][sub] - m0; s[1][sub] = s[1][sub] - m1; }
        }
#pragma unroll
        for (int gp = 0; gp < 2; ++gp) {
            float ps = 0.f;
#pragma unroll
            for (int sub = 0; sub < 4; ++sub)
#pragma unroll
                for (int e = 0; e < 4; ++e) { const float pv = __builtin_amdgcn_exp2f(s[gp][sub][e]); s[gp][sub][e] = pv; ps += pv; }
            lsum[gp] += ps;
            pk[gp][0] = pack8(s[gp][0], s[gp][1]); pk[gp][1] = pack8(s[gp][2], s[gp][3]);
        }
    } else {
#pragma unroll
        for (int gp = 0; gp < 2; ++gp) {
            int rel, lowrel = -1000000;
            if (MODE == 0) rel = ((t[gp] - 31) >> 4) - tile * 64 - 4 * g;
            else { rel = t[gp] - tile * 64 - 4 * g; if (MODE == 2) lowrel = rel - 512; }
            softmax_tile<false>(s[gp], o[gp], pk[gp], mrun[gp], lsum[gp], take[gp], rel, lowrel);
        }
    }
    pv_tile2(o, pk, buf, ql, g);
    if (tile < tile_hi) stage_store<true, true>(R, lds + ((tile + 1) & 1) * BUF_BYTES, tid);
    __syncthreads();
}

template <int MODE>
__device__ __forceinline__ void flash_range(f32x4 (&o)[2][8], float (&lsum)[2], float (&mfin)[2], const bf16x8 (&qf)[2][4], const bf16_t* Kg, const bf16_t* VTg, int vpitch,
                                            int tile_lo, int tile_hi, int tb, const int (&t)[2], const unsigned long long (&selm)[2], LAS unsigned char* lds, int tid, int ql, int g) {
    float mrun[2] = {NEG_BIG, NEG_BIG}; lsum[0] = 0.f; lsum[1] = 0.f;
#pragma unroll
    for (int gp = 0; gp < 2; ++gp)
#pragma unroll
        for (int dt = 0; dt < 8; ++dt) o[gp][dt] = (f32x4){0.f, 0.f, 0.f, 0.f};
    StageRegs R; stage_load<true, true>(R, Kg, VTg, vpitch, tile_lo * 64, tid);
    __syncthreads();
    stage_store<true, true>(R, lds + (tile_lo & 1) * BUF_BYTES, tid);
    __syncthreads();
    int tile = tile_lo;
    if (MODE == 0) {
#pragma unroll 1
        for (; tile <= tile_hi; ++tile) flash_step<MODE, false>(tile, tile_hi, o, lsum, mrun, R, qf, Kg, VTg, vpitch, t, selm, lds, tid, ql, g);
    } else {
        const int d_lo = tile_lo + (MODE == 1 ? 1 : 2);
#pragma unroll 1
        for (; tile <= tile_hi && tile < d_lo; ++tile) flash_step<MODE, false>(tile, tile_hi, o, lsum, mrun, R, qf, Kg, VTg, vpitch, t, selm, lds, tid, ql, g);
#pragma unroll 1
        for (; tile < tile_hi; ++tile) flash_step<MODE, true>(tile, tile_hi, o, lsum, mrun, R, qf, Kg, VTg, vpitch, t, selm, lds, tid, ql, g);
#pragma unroll 1
        for (; tile <= tile_hi; ++tile) flash_step<MODE, false>(tile, tile_hi, o, lsum, mrun, R, qf, Kg, VTg, vpitch, t, selm, lds, tid, ql, g);
    }
    lsum[0] = qsum(lsum[0]); lsum[1] = qsum(lsum[1]); mfin[0] = mrun[0]; mfin[1] = mrun[1];
}

__device__ __forceinline__ void attn_item(const bf16_t* Q, const bf16_t* KV, const bf16_t* KC, const bf16_t* VCT, const float* NG, bf16_t* OATT,
                                          int bg, int tb, LAS unsigned char* lds) {
    int tid = threadIdx.x; asm volatile("" : "+v"(tid));
    const int w = __builtin_amdgcn_readfirstlane(tid >> 6), lane = tid & 63, r = w >> 1, qh = w & 1; int ql = lane & 15, g = lane >> 4;
    asm volatile("" : "+v"(ql), "+v"(g));
    const int b = bg >> 2, gk = bg & 3, h = gk * 4 + r;
    int qq[2], t[2], row[2];
    bf16x8 qf[2][4];
#pragma unroll
    for (int gp = 0; gp < 2; ++gp) {
        qq[gp] = 32 * qh + 16 * gp + ql; t[gp] = 64 * tb + qq[gp]; row[gp] = b * SEQ + t[gp];
#pragma unroll
        for (int kc = 0; kc < 4; ++kc) qf[gp][kc] = *(const bf16x8*)(Q + (size_t)row[gp] * DM + h * 128 + kc * 32 + g * 8);
    }
    { LAS u32x4* z = (LAS u32x4*)(lds + IMP_OFF);
#pragma unroll
      for (int i = 0; i < 8; ++i) z[tid + i * 512] = (u32x4){0u, 0u, 0u, 0u}; }
    const unsigned long long nosel[2] = {0ull, 0ull};
    const bf16_t* KCg = KC + (size_t)bg * 256 * 128; const bf16_t* VCg = VCT + (size_t)bg * 128 * 256;
    const int cmp_hi = (4 * tb + 2) >> 6;
    float mc[2], invc[2];
    {
        f32x4 o[2][8]; float l[2];
        flash_range<0>(o, l, mc, qf, KCg, VCg, 256, 0, cmp_hi, tb, t, nosel, lds, tid, ql, g);
#pragma unroll
        for (int gp = 0; gp < 2; ++gp) {
            invc[gp] = l[gp] > 0.f ? 1.0f / l[gp] : 0.f;
            const float sc = NG[(size_t)row[gp] * 48 + h * 3 + 0] * invc[gp];
#pragma unroll
            for (int dt = 0; dt < 8; ++dt) { const f32x4 v = o[gp][dt] * sc; u32x2 wv; wv.x = cvt_pk_bf16(v[0], v[1]); wv.y = cvt_pk_bf16(v[2], v[3]);
                *(u32x2*)(OATT + (size_t)row[gp] * DM + h * 128 + dt * 16 + 4 * g) = wv; }
        }
    }
    unsigned long long selm[2] = {~0ull, ~0ull};
    if (tb >= 16) {
    {
        StageRegs R; stage_load<true, false>(R, KCg, VCg, 256, 0, tid);
        stage_store<true, false>(R, lds, tid);
        __syncthreads();
#pragma unroll 1
        for (int tile = 0; tile <= cmp_hi; ++tile) {
            const LAS unsigned char* buf = lds + (tile & 1) * BUF_BYTES;
            if (tile < cmp_hi) stage_load<true, false>(R, KCg, VCg, 256, (tile + 1) * 64, tid);
            f32x4 s[2][4]; qk_tile2(s, qf, buf, ql, g);
#pragma unroll
            for (int gp = 0; gp < 2; ++gp) {
                const int rel = ((t[gp] - 31) >> 4) - tile * 64 - 4 * g;
                LAS float* imp = (LAS float*)(lds + IMP_OFF) + (r * 64 + qq[gp]) * 64 + 16 * tile + g;
                float carry[4];
#pragma unroll
                for (int sub = 0; sub < 4; ++sub) {
                    f32x4 p4;
#pragma unroll
                    for (int e = 0; e < 4; ++e) p4[e] = (sub * 16 + e <= rel) ? __builtin_amdgcn_exp2f(s[gp][sub][e] - mc[gp]) * invc[gp] : 0.f;
                    atomicAdd((float*)(imp + 4 * sub), (p4[0] + p4[1]) + (p4[2] + 0.5f * p4[3]));
                    carry[sub] = 0.5f * p4[3];
                }
#pragma unroll
                for (int sub = 0; sub < 4; ++sub) if (16 * tile + 4 * sub + g + 1 < 64) atomicAdd((float*)(imp + 4 * sub + 1), carry[sub]);
            }
            if (tile < cmp_hi) stage_store<true, false>(R, lds + ((tile + 1) & 1) * BUF_BYTES, tid);
            __syncthreads();
        }
    }
    {
#pragma unroll 1
        for (int i = 0; i < 8; ++i) {
            const int q2 = 8 * w + i;
            const LAS float* ip = (const LAS float*)(lds + IMP_OFF) + q2 * 64 + lane;
            float v = ((ip[0] + ip[64 * 64]) + ip[2 * 64 * 64]) + ip[3 * 64 * 64];
            const bool valid = lane <= tb, forced = (lane == 0) || (lane == tb) || (lane == tb - 1);
            v = valid ? (forced ? __builtin_inff() : v) : -__builtin_inff();
            int rank = 0;
#pragma unroll 8
            for (int mm = 0; mm < 64; ++mm) { const float vm = __builtin_bit_cast(float, __builtin_amdgcn_readlane(__builtin_bit_cast(int, v), mm)); rank += (vm > v || (vm == v && mm < lane)) ? 1 : 0; }
            const unsigned long long mask = __ballot(rank < 16);
            if (lane == 0) *(LAS unsigned long long*)(lds + SELM_OFF + q2 * 8) = mask;
        }
    }
    __syncthreads();
    selm[0] = *(const LAS unsigned long long*)(lds + SELM_OFF + qq[0] * 8); selm[1] = *(const LAS unsigned long long*)(lds + SELM_OFF + qq[1] * 8);
    }
    {
        f32x4 o[2][8]; float l[2], mf[2];
        flash_range<1>(o, l, mf, qf, KV + 2 * KVJ + (size_t)bg * SEQ * 128, KV + 3 * KVJ + (size_t)bg * 128 * SEQ, SEQ, 0, tb, tb, t, selm, lds, tid, ql, g);
#pragma unroll
        for (int gp = 0; gp < 2; ++gp) {
            const float sc = NG[(size_t)row[gp] * 48 + h * 3 + 1] / l[gp];
#pragma unroll
            for (int dt = 0; dt < 8; ++dt) {
                u32x2* dst = (u32x2*)(OATT + (size_t)row[gp] * DM + h * 128 + dt * 16 + 4 * g); const u32x2 pr = *dst;
                f32x4 v = o[gp][dt] * sc; v[0] += bflo(pr.x); v[1] += bfhi(pr.x); v[2] += bflo(pr.y); v[3] += bfhi(pr.y);
                u32x2 wv; wv.x = cvt_pk_bf16(v[0], v[1]); wv.y = cvt_pk_bf16(v[2], v[3]); *dst = wv;
            }
        }
    }
    {
        f32x4 o[2][8]; float l[2], mf[2];
        const int tlo = tb > 8 ? tb - 8 : 0;
        flash_range<2>(o, l, mf, qf, KV + 4 * KVJ + (size_t)bg * SEQ * 128, KV + 5 * KVJ + (size_t)bg * 128 * SEQ, SEQ, tlo, tb, tb, t, nosel, lds, tid, ql, g);
#pragma unroll
        for (int gp = 0; gp < 2; ++gp) {
            const float sc = NG[(size_t)row[gp] * 48 + h * 3 + 2] / l[gp];
#pragma unroll
            for (int dt = 0; dt < 8; ++dt) {
                u32x2* dst = (u32x2*)(OATT + (size_t)row[gp] * DM + h * 128 + dt * 16 + 4 * g); const u32x2 pr = *dst;
                f32x4 v = o[gp][dt] * sc; v[0] += bflo(pr.x); v[1] += bfhi(pr.x); v[2] += bflo(pr.y); v[3] += bfhi(pr.y);
                u32x2 wv; wv.x = cvt_pk_bf16(v[0], v[1]); wv.y = cvt_pk_bf16(v[2], v[3]); *dst = wv;
            }
        }
    }
}

enum { MAP_ID = 0, MAP_IN = 1 };
__device__ __forceinline__ int map_in(int n) {
    if (n < 2048) return (n & ~127) + ropeperm(n & 127);
    if (n < 5120) { const int rel = n - 2048, j = rel >> 9, p = rel & 127; const int d = (j == 2 || j == 4) ? ropeperm(p) : p; return 2048 + (rel & ~127) + d; }
    if (n < 11264) return 5168 + (n - 5120);
    if (n < 15360) return 11312 + (n - 11264);
    if (n < 15408) return 5120 + (n - 15360);
    return -1;
}
__device__ __forceinline__ void transpose_item(const float* W, int K, int Nsrc, bf16_t* WT, int Ndst, const float* gain, int maptype, LAS float* scr, int item, int lane) {
    const int nblk = Ndst / 64, kb = item / nblk, nb = item % nblk, k0 = 64 * kb, n0 = 64 * nb;
    const int nd = n0 + lane; const int src = (maptype == MAP_IN) ? map_in(nd) : nd;
    const float* wp = W + (size_t)k0 * Nsrc + (src >= 0 ? src : 0);
#pragma unroll
    for (int h = 0; h < 2; ++h) {
        float v[32];
#pragma unroll
        for (int i = 0; i < 32; ++i) v[i] = wp[(size_t)(32 * h + i) * Nsrc];
#pragma unroll
        for (int i = 0; i < 32; ++i) { float x = (src >= 0) ? v[i] : 0.f; if (gain) x *= gain[k0 + 32 * h + i]; scr[(32 * h + i) * 65 + lane] = x; }
    }
    asm volatile("s_waitcnt lgkmcnt(0)" ::: "memory");
    const int cidx = lane & 7;
#pragma unroll
    for (int j = 0; j < 8; ++j) { const int n = (lane >> 3) + 8 * j; const LAS float* s = scr + (8 * cidx) * 65 + n;
        u32x4 o; o.x = cvt_pk_bf16(s[0 * 65], s[1 * 65]); o.y = cvt_pk_bf16(s[2 * 65], s[3 * 65]); o.z = cvt_pk_bf16(s[4 * 65], s[5 * 65]); o.w = cvt_pk_bf16(s[6 * 65], s[7 * 65]);
        *(u32x4*)(WT + (size_t)(n0 + n) * K + k0 + 8 * cidx) = o; }
    asm volatile("s_waitcnt lgkmcnt(0)" ::: "memory");
}
__device__ __forceinline__ float wave_sum(float v) {
#pragma unroll
    for (int o = 1; o < 64; o <<= 1) v += __shfl_xor(v, o);
    return v;
}

__device__ __forceinline__ void prep_phase(const Params& P, LAS unsigned char* lds) {
    int tid = threadIdx.x; asm volatile("" : "+v"(tid));
    const int wave = tid >> 6, lane = tid & 63;
    const int gw = blockIdx.x * 8 + wave, NGW = gridDim.x * 8;
    const int gt = blockIdx.x * 512 + tid, NGT = gridDim.x * 512;
    unsigned char* ws = P.ws;
    LAS float* scr = (LAS float*)(lds + wave * 16640);
    constexpr int I_IN = (DM / 64) * (NIN / 64), I_SQ = (DM / 64) * (DM / 64), I_UP = (DM / 64) * (FF / 64), I_DN = (FF / 64) * (DM / 64), I_C1 = (4096 / 64) * (256 / 64);
    constexpr int I_LAYER = I_IN + 3 * I_SQ + I_UP + I_DN + 2 * I_C1;
    for (int it = gw; it < DEPTH * I_LAYER; it += NGW) {
        const int L = it / I_LAYER; int r = it % I_LAYER;
        if (r < I_IN) { transpose_item(P.in[2] + (size_t)L * DM * IN_COLS, DM, IN_COLS, (bf16_t*)(ws + WS_WIN) + (size_t)L * NIN * DM, NIN, P.in[1] + L * DM, MAP_IN, scr, r, lane); continue; } r -= I_IN;
        if (r < I_SQ) { transpose_item(P.in[10] + (size_t)L * DM * DM, DM, DM, (bf16_t*)(ws + WS_WAP) + (size_t)L * DM * DM, DM, nullptr, MAP_ID, scr, r, lane); continue; } r -= I_SQ;
        if (r < I_SQ) { transpose_item(P.in[11] + (size_t)L * DM * DM, DM, DM, (bf16_t*)(ws + WS_WCO) + (size_t)L * DM * DM, DM, nullptr, MAP_ID, scr, r, lane); continue; } r -= I_SQ;
        if (r < I_SQ) { transpose_item(P.in[12] + (size_t)L * DM * DM, DM, DM, (bf16_t*)(ws + WS_WO) + (size_t)L * DM * DM, DM, nullptr, MAP_ID, scr, r, lane); continue; } r -= I_SQ;
        if (r < I_UP) { transpose_item(P.in[14] + (size_t)L * DM * FF, DM, FF, (bf16_t*)(ws + WS_WUP) + (size_t)L * FF * DM, FF, P.in[13] + L * DM, MAP_ID, scr, r, lane); continue; } r -= I_UP;
        if (r < I_DN) { transpose_item(P.in[15] + (size_t)L * FF * DM, FF, DM, (bf16_t*)(ws + WS_WDN) + (size_t)L * DM * FF, DM, nullptr, MAP_ID, scr, r, lane); continue; } r -= I_DN;
        if (r < I_C1) { transpose_item(P.in[4] + (size_t)L * 4096 * 256, 4096, 256, (bf16_t*)(ws + WS_CW1) + (size_t)(L * 2 + 0) * 256 * 4096, 256, nullptr, MAP_ID, scr, r, lane); continue; } r -= I_C1;
        transpose_item(P.in[7] + (size_t)L * 4096 * 256, 4096, 256, (bf16_t*)(ws + WS_CW1) + (size_t)(L * 2 + 1) * 256 * 4096, 256, nullptr, MAP_ID, scr, r, lane);
    }
    for (int i = gt; i < DEPTH * 256 * 512; i += NGT) {
        const int L = i / (256 * 512), o = (i >> 9) & 255, k = i & 511; float v = 0.f;
        if (o < 128) { if (k < 256) v = P.in[5][(size_t)L * 256 * 128 + k * 128 + ropeperm(o)]; }
        else { if (k >= 256) v = P.in[8][(size_t)L * 256 * 128 + (k - 256) * 128 + (o - 128)]; }
        ((bf16_t*)(ws + WS_CW2))[i] = (bf16_t)(cvt_pk_bf16(v, 0.f) & 0xffff);
    }
    for (int it = gw; it < DEPTH * 2 * 256; it += NGW) {
        const int L = it >> 9, kv = (it >> 8) & 1, j = it & 255;
        const float* pe = P.in[kv ? 6 : 3] + (size_t)L * 4096; const float* w1 = P.in[kv ? 7 : 4] + (size_t)L * 4096 * 256;
        float s = 0.f; for (int i = lane; i < 4096; i += 64) s += pe[i] * w1[(size_t)i * 256 + j];
        s = wave_sum(s); if (lane == 0) ((float*)(ws + WS_CB))[it] = s;
    }
    for (int i = gt; i < SEQ * 64; i += NGT) {
        const int pos = i >> 6, f = i & 63;
        const float invf = expf(-9.210340371976184f * (float)f / 64.0f);
        const float ang = (float)pos * invf;
        const double rev = (double)ang * 0.15915494309189535; const float fr = (float)(rev - rint(rev));
        ((float*)(ws + WS_ROPE))[i] = __builtin_amdgcn_cosf(fr); ((float*)(ws + WS_ROPE))[SEQ * 64 + i] = __builtin_amdgcn_sinf(fr);
    }
    for (int m = gw; m < T; m += NGW) {
        const f32x4* xr = (const f32x4*)(P.in[0] + (size_t)m * DM) + lane; float s = 0.f;
        u32x2* o8 = (u32x2*)((bf16_t*)(ws + WS_XB) + (size_t)m * DM) + lane;
#pragma unroll
        for (int j = 0; j < 8; ++j) { const f32x4 v = xr[64 * j]; s += (v[0] * v[0] + v[1] * v[1]) + (v[2] * v[2] + v[3] * v[3]); u32x2 w; w.x = cvt_pk_bf16(v[0], v[1]); w.y = cvt_pk_bf16(v[2], v[3]); o8[64 * j] = w; }
        s = wave_sum(s); if (lane == 0) ((float*)(ws + WS_SS))[m] = s;
    }
    for (int i = gt; i < 4 * T; i += NGT) __hip_atomic_store((float*)(ws + WS_SS) + T + i, 0.f, __ATOMIC_RELAXED, __HIP_MEMORY_SCOPE_AGENT);
}

__device__ __forceinline__ void conv_rows(const bf16_t* __restrict__ CV, const float* __restrict__ cw, bf16_t* __restrict__ VB, int gw, int NGW, int lane) {
    for (int item = gw; item < T / 4; item += NGW) {
        const int blk = item >> 1, hc = (item & 1) * 1024, row0 = blk * 8, s0 = row0 & (SEQ - 1);
        float u1[16], u2[16]; float zv = 0.f; asm volatile("" : "+v"(zv));
#pragma unroll
        for (int i = 0; i < 16; ++i) { u1[i] = zv; u2[i] = zv; }
        if (s0 != 0) {
            const bf16_t* rm = CV + (size_t)(row0 - 1) * 6144 + hc;
#pragma unroll
            for (int it = 0; it < 2; ++it) {
                const int ch = it * 512 + lane * 8;
                const u32x4 xa = *(const u32x4*)(rm + ch), ca = *(const u32x4*)(rm + 4096 + ch), xb = *(const u32x4*)(rm - 6144 + ch), cb = *(const u32x4*)(rm - 6144 + 4096 + ch);
#pragma unroll
                for (int e = 0; e < 4; ++e) { u1[it * 8 + 2 * e] = bflo(xa[e]) * bflo(ca[e]); u1[it * 8 + 2 * e + 1] = bfhi(xa[e]) * bfhi(ca[e]);
                                              u2[it * 8 + 2 * e] = bflo(xb[e]) * bflo(cb[e]); u2[it * 8 + 2 * e + 1] = bfhi(xb[e]) * bfhi(cb[e]); }
            }
        }
        float w0[16], w1[16], w2[16];
#pragma unroll
        for (int it = 0; it < 2; ++it)
#pragma unroll
            for (int e = 0; e < 8; ++e) { const int c = hc + it * 512 + lane * 8 + e; w0[it * 8 + e] = cw[c]; w1[it * 8 + e] = cw[DM + c]; w2[it * 8 + e] = cw[2 * DM + c]; }
#pragma unroll 1
        for (int r = 0; r < 8; ++r) {
            const bf16_t* r0 = CV + (size_t)(row0 + r) * 6144 + hc;
            u32x4 x0[2], gb[2], c0[2];
#pragma unroll
            for (int it = 0; it < 2; ++it) { const int ch = it * 512 + lane * 8; x0[it] = *(const u32x4*)(r0 + ch); gb[it] = *(const u32x4*)(r0 + 2048 + ch); c0[it] = *(const u32x4*)(r0 + 4096 + ch); }
#pragma unroll
            for (int it = 0; it < 2; ++it) {
                float res[8];
#pragma unroll
                for (int e = 0; e < 4; ++e) {
                    const int ia = it * 8 + 2 * e, ib = ia + 1;
                    const float ua = bflo(x0[it][e]) * bflo(c0[it][e]), ub = bfhi(x0[it][e]) * bfhi(c0[it][e]);
                    res[2 * e] = bflo(gb[it][e]) * (w0[ia] * u2[ia] + w1[ia] * u1[ia] + w2[ia] * ua);
                    res[2 * e + 1] = bfhi(gb[it][e]) * (w0[ib] * u2[ib] + w1[ib] * u1[ib] + w2[ib] * ub);
                    u2[ia] = u1[ia]; u1[ia] = ua; u2[ib] = u1[ib]; u1[ib] = ub;
                }
                u32x4 o; o.x = cvt_pk_bf16(res[0], res[1]); o.y = cvt_pk_bf16(res[2], res[3]); o.z = cvt_pk_bf16(res[4], res[5]); o.w = cvt_pk_bf16(res[6], res[7]);
                *(u32x4*)(VB + (size_t)(row0 + r) * DM + hc + it * 512 + lane * 8) = o;
            }
        }
    }
}

#define XB_TMO      128
#define XB_XCNT(j)  (256  + 64 * (j))
#define XB_XSUB(j)  (1280 + 64 * (j))
#define XB_XGEN(j)  (2304 + 64 * (j))
#define XB_TOP      3328
#define XB_TOPGEN   3392
#define XCD_BAR_WORDS 3456
#define XB_SPIN_CAP (1u << 22)
__device__ __forceinline__ unsigned xb_ld(unsigned* p)              { return __hip_atomic_load(p, __ATOMIC_RELAXED, __HIP_MEMORY_SCOPE_AGENT); }
__device__ __forceinline__ unsigned xb_add(unsigned* p, unsigned v) { return __hip_atomic_fetch_add(p, v, __ATOMIC_RELAXED, __HIP_MEMORY_SCOPE_AGENT); }
__device__ __forceinline__ unsigned xb_xcc_id() { return (unsigned)__builtin_amdgcn_s_getreg((3 << 11) | 20) & 0xFu; }
#define XB_SPIN(cond, bar) do { unsigned _sp = 0; while (cond) { __builtin_amdgcn_s_sleep(1); \
    if ((++_sp & 255u) == 0u) { if (xb_ld(&(bar)[XB_TMO])) break; if (_sp > XB_SPIN_CAP) { atomicAdd(&(bar)[XB_TMO], 1u); break; } } } } while (0)
struct XcdBarrier { unsigned* bar; unsigned x; volatile LAS unsigned* st; };
__device__ __forceinline__ XcdBarrier xcd_barrier_post(unsigned* bar, volatile LAS unsigned* st) {
    XcdBarrier b; b.bar = bar; b.x = xb_xcc_id(); b.st = st;
    if (threadIdx.x == 0) (void)xb_add(&bar[XB_XCNT(b.x)], 1u);
    return b;
}
__device__ __forceinline__ void xcd_barrier_complete(unsigned* bar, unsigned x, unsigned& nloc, unsigned& nx) {
    const unsigned G = gridDim.x * gridDim.y * gridDim.z;
    unsigned sum, cnt, mine, sp = 0u;
    for (;;) {
        sum = 0u; cnt = 0u; mine = 0u;
#pragma unroll
        for (unsigned j = 0; j < 16; ++j) { const unsigned c = xb_ld(&bar[XB_XCNT(j)]); sum += c; cnt += (c > 0u) ? 1u : 0u; mine = (j == x) ? c : mine; }
        if (sum == G) break;
        __builtin_amdgcn_s_sleep(1);
        if ((++sp & 255u) == 0u) { if (xb_ld(&bar[XB_TMO])) break; if (sp > XB_SPIN_CAP) { atomicAdd(&bar[XB_TMO], 1u); break; } }
    }
    nloc = mine > 0u ? mine : 1u; nx = cnt > 0u ? cnt : 1u;
}
__device__ __forceinline__ void xcd_barrier(const XcdBarrier& b) {
    asm volatile("s_waitcnt vmcnt(0)" ::: "memory");
    __syncthreads();
    if (threadIdx.x == 0) {
        unsigned* bar = b.bar;
        __builtin_amdgcn_s_waitcnt(0);
        unsigned nloc = b.st[0], nx = b.st[1];
        if (nloc == 0u) { xcd_barrier_complete(bar, b.x, nloc, nx); b.st[0] = nloc; b.st[1] = nx; }
        const unsigned old = xb_add(&bar[XB_XSUB(b.x)], 1u);
        const unsigned gen = old / nloc;
        if (old + 1u == (gen + 1u) * nloc) {
            __builtin_amdgcn_fence(__ATOMIC_RELEASE, "agent");
            asm volatile("s_waitcnt vmcnt(0)" ::: "memory");
            const unsigned og = xb_add(&bar[XB_TOP], 1u);
            const unsigned tg = og / nx;
            if (og + 1u == (tg + 1u) * nx) xb_add(&bar[XB_TOPGEN], 1u);
            else XB_SPIN(xb_ld(&bar[XB_TOPGEN]) == tg, bar);
            __builtin_amdgcn_fence(__ATOMIC_ACQUIRE, "agent");
            xb_add(&bar[XB_XGEN(b.x)], 1u);
            asm volatile("s_waitcnt vmcnt(0)" ::: "memory");
        } else {
            XB_SPIN(xb_ld(&bar[XB_XGEN(b.x)]) == gen, bar);
            __builtin_amdgcn_fence(__ATOMIC_ACQUIRE, "agent");
            asm volatile("s_waitcnt vmcnt(0)" ::: "memory");
        }
    }
    __syncthreads();
}

constexpr int LDS_BYTES = 139264;
constexpr int NPH = 1 + 11 * DEPTH + 1;

typedef const __attribute__((address_space(4))) Params* KParams;
__device__ __forceinline__ KParams kparams() { KParams p = (KParams)__builtin_amdgcn_kernarg_segment_ptr(); asm volatile("" : "+s"(p)); return p; }

__global__ void __launch_bounds__(512, 2) nsa_fwd(Params P_unused) {
    extern __shared__ __attribute__((aligned(16))) unsigned char lds_raw[];
    LAS unsigned char* lds = (LAS unsigned char*)lds_raw;
    const int G = gridDim.x;
    int ph = 0;
    int lo, hi, coop; { KParams kp = kparams(); lo = kp->lo; hi = kp->hi; coop = kp->coop; }
    bool bar_up = false; XcdBarrier xbar; xbar.bar = nullptr; xbar.x = 0; xbar.st = nullptr;
    if (coop) {
        if (threadIdx.x < 4) ((volatile LAS unsigned*)(lds + LDS_BYTES - 16))[threadIdx.x] = 0u;
        if (blockIdx.x == 0) { unsigned* bw = (unsigned*)(kparams()->ws + WS_BAR); for (int i = threadIdx.x; i < XCD_BAR_WORDS; i += 512) bw[i] = 0u; }
        __syncthreads();
    }
#define PHASE_BEGIN if (ph >= lo && ph < hi) { KParams kp = kparams(); unsigned char* ws = kp->ws; (void)ws; int tidp = threadIdx.x; asm volatile("" : "+v"(tidp)); int bid = blockIdx.x; asm volatile("" : "+s"(bid)); (void)tidp; (void)bid;
#define PHASE_END   } ++ph; if (coop && ph > lo && ph < hi) { if (!bar_up) { cg::this_grid().sync(); xbar = xcd_barrier_post((unsigned*)(kparams()->ws + WS_BAR), (volatile LAS unsigned*)(lds + LDS_BYTES - 16)); bar_up = true; } else xcd_barrier(xbar); }
#define PHASE_END_NOBAR } ++ph; if (!coop && false) {}
#define PHASE_END_IF(cond) } ++ph; if ((cond) && coop && ph > lo && ph < hi) { xcd_barrier(xbar); }
#define WSP(T_, off) ((T_*)(ws + (off)))

    PHASE_BEGIN { Params Pl; for (int i = 0; i < 17; ++i) Pl.in[i] = kp->in[i]; Pl.out = kp->out; Pl.ws = ws; Pl.lo = 0; Pl.hi = 0; Pl.coop = 0; Pl.pad = 0; prep_phase(Pl, lds); } PHASE_END

#pragma unroll 1
    for (int L = 0; L < DEPTH; ++L) {
        PHASE_BEGIN {
            pg8::Gemm gm{WSP(const bf16_t, WS_XB), WSP(const bf16_t, WS_WIN) + (size_t)L * NIN * DM, T, NIN, DM, DM, DM}; pg8::StaticOrder S; S.init(T, NIN, G, bid);
            const float* ropec = WSP(const float, WS_ROPE);
            EpiIn E{WSP(const float, WS_SS) + (size_t)(2 * L) * T, ropec, ropec + SEQ * 64, WSP(bf16_t, WS_Q), WSP(bf16_t, WS_KV), WSP(bf16_t, WS_CV), WSP(bf16_t, WS_MG), WSP(float, WS_NG)};
            pg8::gemm_phase<EpiIn>(lds, gm, S, E);
        } PHASE_END
        PHASE_BEGIN {
#pragma unroll 1
            for (int u = bid; u < 256; u += G) {
                const int kv = u >> 7, pm = (u >> 3) & 15, ks = u & 7;
                pg8::Gemm gm{WSP(const bf16_t, WS_KV) + (size_t)kv * KVJ + (size_t)pm * 256 * 2048 + ks * 512, WSP(const bf16_t, WS_CW1) + (size_t)(L * 2 + kv) * 256 * 4096 + ks * 512, 256, 256, 512, 2048, 4096};
                pg8::StaticOrder S; S.init(256, 256, 1, 0);
                EpiC1S E{WSP(float, WS_XB) + (size_t)ks * 4096 * 512, pm * 256, kv * 256};
                pg8::gemm_phase<EpiC1S>(lds, gm, S, E);
            }
        } PHASE_END
        PHASE_BEGIN {
            const float* hp = WSP(const float, WS_XB); const float* cb = WSP(const float, WS_CB) + L * 512; bf16_t* hid = WSP(bf16_t, WS_HID);
            for (int i = bid * 512 + tidp; i < 4096 * 512 / 4; i += G * 512) {
                const int c = (i & 127) * 4;
                f32x4 v = *(const f32x4*)(cb + c);
#pragma unroll
                for (int ks = 0; ks < 8; ++ks) v = v + *(const f32x4*)(hp + (size_t)ks * 4096 * 512 + (size_t)i * 4);
#pragma unroll
                for (int e = 0; e < 4; ++e) v[e] = v[e] * sigmoidf_(v[e]);
                u32x2 w; w.x = cvt_pk_bf16(v[0], v[1]); w.y = cvt_pk_bf16(v[2], v[3]);
                *(u32x2*)(hid + (size_t)i * 4) = w;
            }
        } PHASE_END
        PHASE_BEGIN {
            pg8::Gemm gm{WSP(const bf16_t, WS_HID), WSP(const bf16_t, WS_CW2) + (size_t)L * 256 * 512, 4096, 256, 512, 512, 512}; pg8::StaticOrder S; S.init(4096, 256, G, bid);
            EpiC2 E{WSP(float, WS_C2T)};
            if (bid < 16 || G < 64) pg8::gemm_phase<EpiC2>(lds, gm, S, E);
            if (G == 256 && bid < 16) {
                const int bgu = (bid & 7) * 2 + (bid >> 3);
                asm volatile("s_waitcnt vmcnt(0)" ::: "memory"); __syncthreads();
                const float* ropec = WSP(const float, WS_ROPE);
                c2_finish_bg(WSP(const float, WS_C2T), ropec, ropec + SEQ * 64, WSP(bf16_t, WS_KC), WSP(bf16_t, WS_VCT), bgu, tidp);
            } else {
                const int skip = (G == 256) ? 16 : 0;
                conv_rows(WSP(const bf16_t, WS_CV), kp->in[9] + (size_t)L * 3 * DM, WSP(bf16_t, WS_VB), (bid - skip) * 8 + (tidp >> 6), (G - skip) * 8, tidp & 63);
            }
        } PHASE_END
        PHASE_BEGIN {
            if (G != 256) { const float* ropec = WSP(const float, WS_ROPE);
                c2_finish(WSP(const float, WS_C2T), ropec, ropec + SEQ * 64, WSP(bf16_t, WS_KC), WSP(bf16_t, WS_VCT), bid * 512 + tidp, G * 512); }
        } PHASE_END_IF(G != 256)
        PHASE_BEGIN {
            if (G == 256) {
                const int xcd = bid & 7, j = bid >> 3;
#pragma unroll 1
                for (int k = 0; k < 4; ++k) attn_item(WSP(const bf16_t, WS_Q), WSP(const bf16_t, WS_KV), WSP(const bf16_t, WS_KC), WSP(const bf16_t, WS_VCT), WSP(const float, WS_NG), WSP(bf16_t, WS_OATT), 2 * xcd + (k >> 1), (k & 1) ? ((k >> 1) ? 31 - j : j) : 63 - ((k >> 1) ? 31 - j : j), lds);
            } else {
#pragma unroll 1
                for (int i = bid; i < 16 * 64; i += G) attn_item(WSP(const bf16_t, WS_Q), WSP(const bf16_t, WS_KV), WSP(const bf16_t, WS_KC), WSP(const bf16_t, WS_VCT), WSP(const float, WS_NG), WSP(bf16_t, WS_OATT), i & 15, 63 - (i >> 4), lds);
            }
        } PHASE_END
        PHASE_BEGIN {
            pg8::Gemm gm{WSP(const bf16_t, WS_OATT), WSP(const bf16_t, WS_WAP) + (size_t)L * DM * DM, T, DM, DM, DM, DM}; pg8::StaticOrder S; S.init(T, DM, G, bid);
            EpiAP E{WSP(bf16_t, WS_MP), WSP(const bf16_t, WS_MG)};
            pg8::gemm_phase<EpiAP>(lds, gm, S, E);
        } PHASE_END_NOBAR
        PHASE_BEGIN {
            pg8::Gemm gm{WSP(const bf16_t, WS_VB), WSP(const bf16_t, WS_WCO) + (size_t)L * DM * DM, T, DM, DM, DM, DM}; pg8::StaticOrder S; S.init(T, DM, G, bid);
            EpiCO E{WSP(const bf16_t, WS_MP), WSP(const bf16_t, WS_MG), WSP(bf16_t, WS_MB)};
            pg8::gemm_phase<EpiCO>(lds, gm, S, E);
        } PHASE_END
        PHASE_BEGIN {
            pg8::Gemm gm{WSP(const bf16_t, WS_MB), WSP(const bf16_t, WS_WO) + (size_t)L * DM * DM, T, DM, DM, DM, DM}; pg8::StaticOrder S; S.init(T, DM, G, bid);
            EpiRes E{L == 0 ? kp->in[0] : (const float*)kp->out, kp->out, WSP(bf16_t, WS_XB), WSP(float, WS_SS) + (size_t)(2 * L + 1) * T};
            pg8::gemm_phase<EpiRes>(lds, gm, S, E);
        } PHASE_END
        PHASE_BEGIN {
            pg8::Gemm gm{WSP(const bf16_t, WS_XB), WSP(const bf16_t, WS_WUP) + (size_t)L * FF * DM, T, FF, DM, DM, DM}; pg8::StaticOrder S; S.init(T, FF, G, bid);
            EpiUp E{WSP(const float, WS_SS) + (size_t)(2 * L + 1) * T, WSP(bf16_t, WS_H)};
            pg8::gemm_phase<EpiUp>(lds, gm, S, E);
        } PHASE_END
        PHASE_BEGIN {
            pg8::Gemm gm{WSP(const bf16_t, WS_H), WSP(const bf16_t, WS_WDN) + (size_t)L * DM * FF, T, DM, FF, FF, FF}; pg8::StaticOrder S; S.init(T, DM, G, bid);
            EpiRes E{(const float*)kp->out, kp->out, L + 1 < DEPTH ? WSP(bf16_t, WS_XB) : (bf16_t*)nullptr, WSP(float, WS_SS) + (size_t)(2 * L + 2) * T};
            pg8::gemm_phase<EpiRes>(lds, gm, S, E);
        } PHASE_END
    }
    PHASE_BEGIN {
        const float* ssf = WSP(const float, WS_SS) + (size_t)(2 * DEPTH) * T; const float* fg = kp->in[16]; float* out = kp->out;
        const int nloc = (G == 256) ? 2048 * 512 : T * (DM / 4), i0 = (G == 256) ? (bid >> 3) * 512 + tidp : bid * 512 + tidp, istep = (G == 256) ? 32 * 512 : G * 512, ibase = (G == 256) ? (bid & 7) * 2048 * 512 : 0;
        for (int il = i0; il < nloc; il += istep) {
            const int i = ibase + il;
            const int row = i >> 9, c4 = i & 511;
            const float rstd = rsqrtf(ssf[row] * (1.0f / DM) + EPS);
            const f32x4 gq = *(const f32x4*)(fg + 4 * c4);
            f32x4 v = *(f32x4*)(out + (size_t)i * 4);
            v = v * rstd * gq;
            *(f32x4*)(out + (size_t)i * 4) = v;
        }
    } PHASE_END
#undef PHASE_BEGIN
#undef PHASE_END
#undef WSP
}

#ifndef N_LAUNCH_MODE
#define N_LAUNCH_MODE 1
#endif
extern "C" void kernel_launch(void* const* d_in, const int* in_sizes, int n_in, void* d_out, int out_size, void* d_ws, size_t ws_size, hipStream_t stream) {
    static int grid = 0;
    if (grid == 0) {
        if (n_in != 17 || out_size != T * DM || ws_size < WS_END) { fprintf(stderr, "kernel_launch: unexpected problem (n_in %d out %d ws %zu, need %zu)\n", n_in, out_size, ws_size, (size_t)WS_END); grid = -1; return; }
        int dev = 0, cus = 0, per_cu = 0;
        hipGetDevice(&dev); hipDeviceGetAttribute(&cus, hipDeviceAttributeMultiprocessorCount, dev);
        if (hipFuncSetAttribute((const void*)nsa_fwd, hipFuncAttributeMaxDynamicSharedMemorySize, LDS_BYTES) != hipSuccess) { fprintf(stderr, "kernel_launch: hipFuncSetAttribute failed\n"); grid = -1; return; }
        if (hipOccupancyMaxActiveBlocksPerMultiprocessor(&per_cu, (const void*)nsa_fwd, 512, LDS_BYTES) != hipSuccess || per_cu < 1) { fprintf(stderr, "kernel_launch: occupancy query says %d\n", per_cu); per_cu = 1; }
        (void)hipGetLastError();
        grid = cus * (per_cu > 1 ? 1 : per_cu);
        if (grid <= 0) grid = 256;
    }
    if (grid < 0) return;
    Params p{};
    for (int i = 0; i < 17; ++i) p.in[i] = (const float*)d_in[i];
    p.out = (float*)d_out; p.ws = (unsigned char*)d_ws;
#if N_LAUNCH_MODE == 1
    p.lo = 0; p.hi = NPH; p.coop = 1;
    void* args[] = {&p};
    hipError_t e = hipLaunchCooperativeKernel((const void*)nsa_fwd, dim3(grid), dim3(512), args, LDS_BYTES, stream);
    if (e != hipSuccess) fprintf(stderr, "cooperative launch failed: %s (grid %d)\n", hipGetErrorString(e), grid);
#else
    for (int ph = 0; ph < NPH; ++ph) {
        p.lo = ph; p.hi = ph + 1; p.coop = 0;
        hipLaunchKernelGGL(nsa_fwd, dim3(grid), dim3(512), LDS_BYTES, stream, p);
    }
#endif
}
```
